# Optimizing an MI355X kernel written in HIP

```python
import jax, jax.numpy as jnp
from jax import lax
import numpy as np

D_MODEL = 2048
BATCH = 16
SEQ = 256
DEPTH = 4
DEC_BATCH = 4
DEC_SEQ = 1024
PAST_LEN = 256

GRID_W = 64
EPS = 1e-6
ROPE_BASE = 10000.0
Q_BLOCK = 128
D_RNN = D_MODEL // 2
LRU_BLOCKS = 8
LRU_BS = D_RNN // LRU_BLOCKS
CONV_W = 4
LRU_C = 8.0
MLA_HEADS = 8
MLA_NOPE = 128
MLA_ROPE = 64
MLA_V = 128
MLA_Q_RANK = D_MODEL // 4
MLA_KV_RANK = D_MODEL // 8
RET_HEADS = 8
RET_DK = 128
RET_DV = 128
RET_CHUNK = 128
D_FF = 4 * D_MODEL
N_BRANCH = 3

COL_SIZES = (D_RNN, D_RNN, MLA_Q_RANK, MLA_KV_RANK, MLA_ROPE,
             RET_HEADS * RET_DK, RET_HEADS * RET_DK, RET_HEADS * RET_DV, RET_HEADS * RET_DV,
             N_BRANCH * D_MODEL)
N_IN = sum(COL_SIZES)
SPLITS = tuple(sum(COL_SIZES[:i + 1]) for i in range(len(COL_SIZES) - 1))

kernel_name = "hybrid_lru_mla_retention_dit_step"


def rms_norm(x, g):
    xf = x.astype(jnp.float32)
    y = xf * lax.rsqrt(jnp.mean(xf * xf, axis=-1, keepdims=True) + EPS)
    return (y * g.astype(jnp.float32)).astype(x.dtype)


def head_norm(x):
    xf = x.astype(jnp.float32)
    mu = jnp.mean(xf, axis=-1, keepdims=True)
    var = jnp.mean(jnp.square(xf - mu), axis=-1, keepdims=True)
    return (xf - mu) * lax.rsqrt(var + EPS)


def modulate(h, shift, scale):
    return h * (1.0 + scale) + shift


def ada_params(cond, w_mod, b_mod):
    return jnp.split(jax.nn.silu(cond) @ w_mod + b_mod, 6, axis=-1)


def axial_rope(x):
    T = x.shape[1]
    half = x.shape[-1] // 2
    rows = T // GRID_W
    row = jnp.repeat(jnp.arange(rows), GRID_W).astype(jnp.float32)
    col = jnp.tile(jnp.arange(GRID_W), rows).astype(jnp.float32)
    inv = ROPE_BASE ** (-jnp.arange(0, half, 2, dtype=jnp.float32) / half)
    bshape = (1, T) + (1,) * (x.ndim - 3) + (half // 2,)

    def rot(xp, pos):
        ang = (pos[:, None] * inv[None, :]).reshape(bshape)
        cos, sin = jnp.cos(ang), jnp.sin(ang)
        x1, x2 = jnp.split(xp.astype(jnp.float32), 2, axis=-1)
        return jnp.concatenate([x1 * cos - x2 * sin, x2 * cos + x1 * sin], axis=-1)

    return jnp.concatenate([rot(x[..., :half], row), rot(x[..., half:], col)], axis=-1).astype(x.dtype)


def rglru_direction(xb, conv_w, conv_b, wa, ba, wx, bx, lam, h0):
    B, T, _ = xb.shape
    xc = lax.conv_general_dilated(xb, conv_w[:, None, :].astype(xb.dtype), window_strides=(1,),
                                  padding=[(CONV_W - 1, 0)], dimension_numbers=("NWC", "WIO", "NWC"),
                                  feature_group_count=D_RNN) + conv_b
    xr = xc.reshape(B, T, LRU_BLOCKS, LRU_BS)
    r = jax.nn.sigmoid((jnp.einsum("btnc,ncd->btnd", xr, wa).reshape(B, T, D_RNN) + ba).astype(jnp.float32))
    i = jax.nn.sigmoid((jnp.einsum("btnc,ncd->btnd", xr, wx).reshape(B, T, D_RNN) + bx).astype(jnp.float32))
    log_a = -LRU_C * r * jax.nn.softplus(-lam.astype(jnp.float32))
    a = jnp.exp(log_a)
    b = jnp.sqrt(-jnp.expm1(2.0 * log_a)) * (i * xc.astype(jnp.float32))

    def step(h, ab):
        h = ab[0] * h + ab[1]
        return h, h

    h_last, hs = lax.scan(step, h0.astype(jnp.float32), (a.swapaxes(0, 1), b.swapaxes(0, 1)))
    return hs.swapaxes(0, 1).astype(xb.dtype), h_last


def rglru_branch(x_rnn, x_gate, p, h0_f, h0_b):
    dirs = []
    for d, (xd, h0) in enumerate(((x_rnn, h0_f), (x_rnn[:, ::-1], h0_b))):
        dirs.append(rglru_direction(xd, p["lru_conv_w"][d], p["lru_conv_b"][d], p["lru_wa"][d], p["lru_ba"][d],
                                    p["lru_wx"][d], p["lru_bx"][d], p["lru_lam"][d], h0))
    (y_f, h_f), (y_b, h_b) = dirs
    y = (y_f + y_b[:, ::-1]) * jax.nn.gelu(x_gate)
    return y @ p["w_br_lru"], jnp.stack([h_f, h_b], axis=1)


def retention_direction(q, k, v, log_g, s0):
    B, T, H, _ = q.shape
    n_chunks = T // RET_CHUNK

    def chunks(t):
        return t.astype(jnp.float32).reshape(B, n_chunks, RET_CHUNK, H, t.shape[-1]).swapaxes(0, 1)

    pos = jnp.arange(RET_CHUNK, dtype=jnp.float32)
    diff = pos[:, None] - pos[None, :]
    inner_decay = jnp.where(diff >= 0, jnp.exp(log_g[:, None, None] * jnp.maximum(diff, 0.0)), 0.0)
    q_decay = jnp.exp(log_g[None, :] * (pos[:, None] + 1.0))
    k_decay = jnp.exp(log_g[None, :] * (RET_CHUNK - 1.0 - pos[:, None]))
    chunk_decay = jnp.exp(log_g * RET_CHUNK)

    def step(s, qkv):
        qc, kc, vc = qkv
        scores = jnp.einsum("bqhd,bkhd->bhqk", qc, kc) * inner_decay
        o = (jnp.einsum("bhqk,bkhe->bqhe", scores, vc)
             + jnp.einsum("bqhd,bhde->bqhe", qc * q_decay[None, :, :, None], s))
        s = (chunk_decay[None, :, None, None] * s
             + jnp.einsum("bkhd,bkhe->bhde", kc * k_decay[None, :, :, None], vc))
        return s, o

    s_last, o = lax.scan(step, s0.astype(jnp.float32), (chunks(q), chunks(k), chunks(v)))
    return o.swapaxes(0, 1).reshape(B, T, H, v.shape[-1]), s_last


def retention_branch(rq, rk, rv, rg, decay_logit, w_br, s0_f, s0_b, rotate):
    B, T, _ = rq.shape
    q = rq.reshape(B, T, RET_HEADS, RET_DK)
    k = rk.reshape(B, T, RET_HEADS, RET_DK) * (RET_DK ** -0.5)
    v = rv.reshape(B, T, RET_HEADS, RET_DV)
    if rotate:
        q, k = axial_rope(q), axial_rope(k)
    log_g = jax.nn.log_sigmoid(decay_logit.astype(jnp.float32))
    o_f, s_f = retention_direction(q, k, v, log_g[0], s0_f)
    o_b, s_b = retention_direction(q[:, ::-1], k[:, ::-1], v[:, ::-1], log_g[1], s0_b)
    o = head_norm(o_f + o_b[:, ::-1]).reshape(B, T, RET_HEADS * RET_DV).astype(rg.dtype) * jax.nn.silu(rg)
    return o @ w_br, jnp.stack([s_f, s_b], axis=1)


def mla_queries(cq_raw, g_q, w_uq, rotate):
    B, T, _ = cq_raw.shape
    q = (rms_norm(cq_raw, g_q) @ w_uq).reshape(B, T, MLA_HEADS, MLA_NOPE + MLA_ROPE)
    q_nope, q_rope = q[..., :MLA_NOPE], q[..., MLA_NOPE:]
    if rotate:
        q_rope = axial_rope(q_rope)
    return q_nope, q_rope


def mla_attend(q_nope, q_rope, ckv, k_rope, w_ukv, w_br):
    B, T = q_nope.shape[:2]
    S = ckv.shape[1]
    kv = (ckv @ w_ukv).reshape(B, S, MLA_HEADS, MLA_NOPE + MLA_V)
    k_nope, v = kv[..., :MLA_NOPE], kv[..., MLA_NOPE:]
    scale = (MLA_NOPE + MLA_ROPE) ** -0.5
    n_blocks = T // Q_BLOCK

    def blocks(t):
        return t.reshape((B, n_blocks, Q_BLOCK) + t.shape[2:]).swapaxes(0, 1)

    def attend(qs):
        qn, qr = qs
        s = jnp.einsum("bqhd,bkhd->bhqk", qn, k_nope) + jnp.einsum("bqhd,bkd->bhqk", qr, k_rope)
        pr = jax.nn.softmax(s.astype(jnp.float32) * scale, axis=-1).astype(v.dtype)
        return jnp.einsum("bhqk,bkhd->bqhd", pr, v)

    o = lax.map(attend, (blocks(q_nope), blocks(q_rope)))
    o = o.swapaxes(0, 1).reshape(B, T, MLA_HEADS * MLA_V)
    return o @ w_br


def merge_branches(gate_logits, u_lru, u_mla, u_ret, w_out):
    g = jax.nn.sigmoid(gate_logits.astype(jnp.float32)).astype(u_lru.dtype)
    g_lru, g_mla, g_ret = jnp.split(g, N_BRANCH, axis=-1)
    return (g_lru * u_lru + g_mla * u_mla + g_ret * u_ret) @ w_out


def mixer_context(h, p):
    x_rnn, x_gate, cq, ckv_raw, kr, rq, rk, rv, rg, gates = jnp.split(h @ p["w_in"], SPLITS, axis=-1)
    B = h.shape[0]
    h0 = jnp.zeros((B, D_RNN), jnp.float32)
    u_lru, st_lru = rglru_branch(x_rnn, x_gate, p, h0, h0)
    ckv = rms_norm(ckv_raw, p["mla_gkv"])
    qn, qr = mla_queries(cq, p["mla_gq"], p["mla_wuq"], rotate=False)
    u_mla = mla_attend(qn, qr, ckv, kr, p["mla_wukv"], p["w_br_mla"])
    s0 = jnp.zeros((B, RET_HEADS, RET_DK, RET_DV), jnp.float32)
    u_ret, st_ret = retention_branch(rq, rk, rv, rg, p["ret_decay"], p["w_br_ret"], s0, s0, rotate=False)
    return merge_branches(gates, u_lru, u_mla, u_ret, p["w_out"]), ckv, kr, st_lru, st_ret


def mixer_latent(h, p, ckv_ctx, kr_ctx, st_lru, st_ret):
    x_rnn, x_gate, cq, ckv_raw, kr, rq, rk, rv, rg, gates = jnp.split(h @ p["w_in"], SPLITS, axis=-1)
    u_lru, _ = rglru_branch(x_rnn, x_gate, p, st_lru[:, 0], st_lru[:, 1])
    ckv = jnp.concatenate([ckv_ctx.astype(h.dtype), rms_norm(ckv_raw, p["mla_gkv"])], axis=1)
    k_rope = jnp.concatenate([kr_ctx.astype(h.dtype), axial_rope(kr)], axis=1)
    qn, qr = mla_queries(cq, p["mla_gq"], p["mla_wuq"], rotate=True)
    u_mla = mla_attend(qn, qr, ckv, k_rope, p["mla_wukv"], p["w_br_mla"])
    u_ret, _ = retention_branch(rq, rk, rv, rg, p["ret_decay"], p["w_br_ret"], st_ret[:, 0], st_ret[:, 1],
                                rotate=True)
    return merge_branches(gates, u_lru, u_mla, u_ret, p["w_out"])


def ffn_sublayer(x, shift, scale, gate, g_pre, g_post, w1, w2):
    h = modulate(rms_norm(x, g_pre), shift, scale)
    y = jnp.square(jax.nn.relu(h @ w1)) @ w2
    return x + gate * rms_norm(y, g_post)


def setup_inputs(seed: int = 0) -> dict:
    key = jax.random.key(seed)
    ks = iter(jax.random.split(key, 40))
    D = D_MODEL

    def nrm(shape, scale):
        return jax.random.normal(next(ks), shape, jnp.float32) * scale

    x_prompt = nrm((BATCH, SEQ, D), 1.0)
    x_sample = nrm((DEC_BATCH, DEC_SEQ, D), 1.0)
    c = nrm((DEC_BATCH, D), 1.0)
    cache_mla_ckv = nrm((DEC_BATCH, DEPTH, PAST_LEN, MLA_KV_RANK), 1.0)
    cache_mla_krope = nrm((DEC_BATCH, DEPTH, PAST_LEN, MLA_ROPE), 1.0)
    state_lru = nrm((DEC_BATCH, DEPTH, 2, D_RNN), 0.5)
    state_ret = nrm((DEC_BATCH, DEPTH, 2, RET_HEADS, RET_DK, RET_DV), RET_DK ** -0.5)
    c_ctx = nrm((D,), 1.0)
    w_mod = nrm((DEPTH, D, 6 * D), 0.5 * D ** -0.5)
    b_mod = nrm((DEPTH, 6 * D), 0.01)
    g_norm = 1.0 + nrm((DEPTH, 4, D), 0.01)
    w_in = nrm((DEPTH, D, N_IN), D ** -0.5)
    lru_conv_w = nrm((DEPTH, 2, CONV_W, D_RNN), CONV_W ** -0.5)
    lru_conv_b = nrm((DEPTH, 2, D_RNN), 0.01)
    lru_wa = nrm((DEPTH, 2, LRU_BLOCKS, LRU_BS, LRU_BS), LRU_BS ** -0.5)
    lru_ba = nrm((DEPTH, 2, D_RNN), 0.01)
    lru_wx = nrm((DEPTH, 2, LRU_BLOCKS, LRU_BS, LRU_BS), LRU_BS ** -0.5)
    lru_bx = nrm((DEPTH, 2, D_RNN), 0.01)
    a_base = jax.random.uniform(next(ks), (DEPTH, 2, D_RNN), jnp.float32, 0.9, 0.999) ** (1.0 / LRU_C)
    lru_lam = jnp.log(a_base) - jnp.log1p(-a_base)
    mla_gq = 1.0 + nrm((DEPTH, MLA_Q_RANK), 0.01)
    mla_gkv = 1.0 + nrm((DEPTH, MLA_KV_RANK), 0.01)
    mla_wuq = nrm((DEPTH, MLA_Q_RANK, MLA_HEADS * (MLA_NOPE + MLA_ROPE)), MLA_Q_RANK ** -0.5)
    mla_wukv = nrm((DEPTH, MLA_KV_RANK, MLA_HEADS * (MLA_NOPE + MLA_V)), MLA_KV_RANK ** -0.5)
    gamma = 1.0 - 2.0 ** (-5.0 - jnp.arange(RET_HEADS, dtype=jnp.float32))
    ret_decay = jnp.log(gamma) - jnp.log1p(-gamma) + nrm((DEPTH, 2, RET_HEADS), 0.01)
    w_br_lru = nrm((DEPTH, D_RNN, D), D_RNN ** -0.5)
    w_br_mla = nrm((DEPTH, MLA_HEADS * MLA_V, D), (MLA_HEADS * MLA_V) ** -0.5)
    w_br_ret = nrm((DEPTH, RET_HEADS * RET_DV, D), (RET_HEADS * RET_DV) ** -0.5)
    w_out = nrm((DEPTH, D, D), D ** -0.5)
    w_ff1 = nrm((DEPTH, D, D_FF), D ** -0.5)
    w_ff2 = nrm((DEPTH, D_FF, D), D_FF ** -0.5)
    return {"x_prompt": x_prompt, "x_sample": x_sample, "c": c,
            "cache_mla_ckv": cache_mla_ckv, "cache_mla_krope": cache_mla_krope,
            "state_lru": state_lru, "state_ret": state_ret,
            "c_ctx": c_ctx, "w_mod": w_mod, "b_mod": b_mod, "g_norm": g_norm, "w_in": w_in,
            "lru_conv_w": lru_conv_w, "lru_conv_b": lru_conv_b, "lru_wa": lru_wa, "lru_ba": lru_ba,
            "lru_wx": lru_wx, "lru_bx": lru_bx, "lru_lam": lru_lam,
            "mla_gq": mla_gq, "mla_gkv": mla_gkv, "mla_wuq": mla_wuq, "mla_wukv": mla_wukv,
            "ret_decay": ret_decay, "w_br_lru": w_br_lru, "w_br_mla": w_br_mla, "w_br_ret": w_br_ret,
            "w_out": w_out, "w_ff1": w_ff1, "w_ff2": w_ff2}


def reference(x_prompt, x_sample, c, cache_mla_ckv, cache_mla_krope, state_lru, state_ret,
              c_ctx, w_mod, b_mod, g_norm, w_in, lru_conv_w, lru_conv_b, lru_wa, lru_ba, lru_wx, lru_bx,
              lru_lam, mla_gq, mla_gkv, mla_wuq, mla_wukv, ret_decay, w_br_lru, w_br_mla, w_br_ret,
              w_out, w_ff1, w_ff2):
    xp, xs = x_prompt, x_sample
    cond_ctx = c_ctx[None, None, :]
    cond_lat = c[:, None, :]
    ckv_out, kr_out, lru_out, ret_out = [], [], [], []
    for l in range(DEPTH):
        p = {"w_in": w_in[l], "lru_conv_w": lru_conv_w[l], "lru_conv_b": lru_conv_b[l],
             "lru_wa": lru_wa[l], "lru_ba": lru_ba[l], "lru_wx": lru_wx[l], "lru_bx": lru_bx[l],
             "lru_lam": lru_lam[l], "mla_gq": mla_gq[l], "mla_gkv": mla_gkv[l], "mla_wuq": mla_wuq[l],
             "mla_wukv": mla_wukv[l], "ret_decay": ret_decay[l], "w_br_lru": w_br_lru[l],
             "w_br_mla": w_br_mla[l], "w_br_ret": w_br_ret[l], "w_out": w_out[l]}

        sh1, sc1, ga1, sh2, sc2, ga2 = ada_params(cond_ctx, w_mod[l], b_mod[l])
        h = modulate(rms_norm(xp, g_norm[l, 0]), sh1, sc1)
        u, ckv, kr, st_l, st_r = mixer_context(h, p)
        xp = xp + ga1 * rms_norm(u, g_norm[l, 1])
        xp = ffn_sublayer(xp, sh2, sc2, ga2, g_norm[l, 2], g_norm[l, 3], w_ff1[l], w_ff2[l])
        ckv_out.append(ckv)
        kr_out.append(kr)
        lru_out.append(st_l.astype(x_prompt.dtype))
        ret_out.append(st_r.astype(x_prompt.dtype))

        sh1, sc1, ga1, sh2, sc2, ga2 = ada_params(cond_lat, w_mod[l], b_mod[l])
        h = modulate(rms_norm(xs, g_norm[l, 0]), sh1, sc1)
        u = mixer_latent(h, p, cache_mla_ckv[:, l], cache_mla_krope[:, l], state_lru[:, l], state_ret[:, l])
        xs = xs + ga1 * rms_norm(u, g_norm[l, 1])
        xs = ffn_sublayer(xs, sh2, sc2, ga2, g_norm[l, 2], g_norm[l, 3], w_ff1[l], w_ff2[l])

    y_prompt, y_sample = xp, xs
    new_mla_ckv = jnp.stack(ckv_out, axis=1)
    new_mla_krope = jnp.stack(kr_out, axis=1)
    new_state_lru = jnp.stack(lru_out, axis=1)
    new_state_ret = jnp.stack(ret_out, axis=1)
    return (y_prompt, y_sample, new_mla_ckv, new_mla_krope, new_state_lru, new_state_ret)
```

```cpp
#define FX_DBG 0
#define FX_TL 0
#include <hip/hip_runtime.h>
#include <cstdio>
#include <cstring>
#include <cmath>
#include <cstdint>

#define GAS __attribute__((address_space(1)))
#define LAS __attribute__((address_space(3)))
typedef unsigned short bf16_t;
typedef short bf16x8 __attribute__((ext_vector_type(8)));
typedef short s16x4 __attribute__((ext_vector_type(4)));
typedef float f32x2 __attribute__((ext_vector_type(2)));
typedef float f32x4 __attribute__((ext_vector_type(4)));
typedef float f32x16 __attribute__((ext_vector_type(16)));
typedef unsigned u32x2 __attribute__((ext_vector_type(2)));
typedef unsigned u32x4 __attribute__((ext_vector_type(4)));
typedef __bf16 bf16v2_t __attribute__((ext_vector_type(2)));

namespace fx {
constexpr int D = 2048, NTOK = 8192, NCTX = 4096, NL = 4, DR = 1024, FF = 8192, NINP = 13312, NKEY = 9216, NWAVES = 8, NTHR = 512;
constexpr int NCOND = 5, NADA = 6 * D;
#ifndef FX_DBG
#define FX_DBG 0
#endif
constexpr size_t SZ_WIN = (size_t)NINP * D * 2, SZ_WUQ = (size_t)1536 * 512 * 2, SZ_WUKV = (size_t)2048 * 256 * 2, SZ_WBR = (size_t)3 * 2048 * 1024 * 2, SZ_WOUT = (size_t)D * D * 2,
                 SZ_W1 = (size_t)FF * D * 2, SZ_W2 = (size_t)D * FF * 2, SZ_LRUW = (size_t)2 * 8 * 2 * 128 * 128 * 2;
constexpr size_t WO_WIN = 0, WO_WUQ = WO_WIN + SZ_WIN, WO_WUKV = WO_WUQ + SZ_WUQ, WO_WBR = WO_WUKV + SZ_WUKV, WO_WOUT = WO_WBR + SZ_WBR, WO_W1 = WO_WOUT + SZ_WOUT, WO_W2 = WO_W1 + SZ_W1,
                 WO_LRUW = WO_W2 + SZ_W2, W_LAYER = WO_LRUW + SZ_LRUW;
constexpr size_t WL_STRIDE = FX_DBG ? 0 : W_LAYER;
constexpr int W_SLOTS = FX_DBG ? 1 : NL;
constexpr size_t al256(size_t x) { return (x + 255) & ~(size_t)255; }
constexpr size_t WS_CTL = 0, CTL_BYTES = 1u << 20;
constexpr size_t WS_ADAP = WS_CTL + CTL_BYTES, SZ_ADAP = (size_t)4 * NL * NCOND * NADA * 4;
constexpr size_t WS_ADA = WS_ADAP + SZ_ADAP, SZ_ADA = (size_t)NL * NCOND * NADA * 4;
constexpr size_t WS_TABR = WS_ADA + SZ_ADA, SZ_TABR = 64 * 32 * 8, WS_TABM = WS_TABR + SZ_TABR, SZ_TABM = 64 * 16 * 8;
constexpr size_t WS_W = al256(WS_TABM + SZ_TABM);
constexpr size_t WS_H = al256(WS_W + W_LAYER * W_SLOTS), SZ_H = (size_t)NTOK * D * 2;
constexpr size_t WS_RNN = WS_H + SZ_H, SZ_RNN = (size_t)NTOK * 2048 * 2;
constexpr size_t WS_RET = WS_RNN + SZ_RNN, SZ_RET = (size_t)NTOK * 4096 * 2;
constexpr size_t WS_GATES = WS_RET + SZ_RET, SZ_GATES = (size_t)NTOK * 6144 * 2;
constexpr size_t WS_MLAR = WS_GATES + SZ_GATES, SZ_MLAR = (size_t)NTOK * 1024 * 4;
constexpr size_t WS_LA = WS_MLAR + SZ_MLAR, SZ_LAB = (size_t)2 * NTOK * DR * 4, WS_LB = WS_LA + SZ_LAB;
constexpr size_t WS_HSF = WS_LB + SZ_LAB, SZ_HSF = (size_t)NTOK * DR * 4;
constexpr size_t WS_YCAT = WS_HSF + SZ_HSF, SZ_YCAT = (size_t)3 * NTOK * 1024 * 2;
constexpr size_t WS_CQN = WS_YCAT + SZ_YCAT, SZ_CQN = (size_t)NTOK * 512 * 2;
constexpr size_t WS_CKVA = WS_CQN + SZ_CQN, SZ_CKVA = (size_t)NKEY * 256 * 2;
constexpr size_t WS_KRA = WS_CKVA + SZ_CKVA, SZ_KRA = (size_t)NKEY * 64 * 2;
constexpr size_t WS_QMLA = WS_KRA + SZ_KRA, SZ_QMLA = (size_t)NTOK * 1536 * 2;
constexpr size_t WS_KN = WS_QMLA + SZ_QMLA, SZ_KN = (size_t)NKEY * 1024 * 2, WS_VM = WS_KN + SZ_KN;
constexpr size_t WS_TMP = WS_VM + SZ_KN, SZ_TMP = (size_t)NTOK * D * 4;
constexpr size_t WS_MERGED = WS_TMP + SZ_TMP, SZ_MERGED = (size_t)NTOK * D * 2;
constexpr size_t WS_U = WS_MERGED + SZ_MERGED, SZ_U = (size_t)NTOK * D * 4;
constexpr size_t WS_HID = WS_U + SZ_U, SZ_HID = (size_t)NTOK * FF * 2;
constexpr size_t WS_FAST_END = WS_HID + SZ_HID;
constexpr int CW_BAR = 4096;
constexpr int LDS_BYTES = 147456, LDS_MISC = 135168;
constexpr long OUT_Y = 0, OUT_CKV = (long)NTOK * D, OUT_KROPE = OUT_CKV + (long)16 * NL * 256 * 256, OUT_LRU = OUT_KROPE + (long)16 * NL * 256 * 64, OUT_RET = OUT_LRU + (long)16 * NL * 2 * DR,
               OUT_END = OUT_RET + (long)16 * NL * 2 * 8 * 128 * 128;

__device__ __forceinline__ float bf2f(unsigned short b) { return __uint_as_float(((unsigned)b) << 16); }
__device__ __forceinline__ unsigned pk2(float lo, float hi) { f32x2 v = {lo, hi}; bf16v2_t b = __builtin_convertvector(v, bf16v2_t); return __builtin_bit_cast(unsigned, b); }
__device__ __forceinline__ float lo_bf(unsigned w) { return __uint_as_float(w << 16); }
__device__ __forceinline__ float hi_bf(unsigned w) { return __uint_as_float(w & 0xffff0000u); }
__device__ __forceinline__ float wave_sum(float v) {
#pragma unroll
    for (int o = 1; o < 64; o <<= 1) v += __shfl_xor(v, o);
    return v;
}
__device__ __forceinline__ float fsigm(float x) { return 1.0f / (1.0f + __expf(-x)); }
__device__ __forceinline__ int crow(int r, int hi) { return (r & 3) + 8 * (r >> 2) + 4 * hi; }
__device__ __forceinline__ int cond_of(int m) { return m < NCTX ? 0 : 1 + ((m - NCTX) >> 10); }
__device__ __host__ __forceinline__ int ret_old_of_new(int n) { const int blk = n >> 6, w = n & 63; return 64 * blk + (w >> 1) + 32 * (w & 1); }
__device__ __host__ __forceinline__ int ret_new_of_old(int d) { const int blk = d >> 6, w = d & 63; return 64 * blk + 2 * (w & 31) + (w >> 5); }
__device__ __host__ __forceinline__ int mla_new_of_old(int d) { const int blk = d >> 5, w = d & 31; return 32 * blk + 2 * (w & 15) + (w >> 4); }

struct P {
    const float* in[30];
    float* out;
    float* xres;
    unsigned char* ws;
    int ph_lo, ph_hi;
    int l_lo, l_hi;
};
static_assert(sizeof(P) == 30 * 8 + 3 * 8 + 16, "P has no padding");
}

namespace pg8 {
#define PG8_LAS __attribute__((address_space(3)))
constexpr int BM = 256, BK = 64, HALF = 128, HTB = HALF * BK * 2  , STAGE_BYTES = 8 * HTB, NXCD = 8, WGM = 8;

__host__ __device__ __forceinline__ int lds_byte(int r, int c) { const int st = (r >> 4) * 2 + (c >> 5), rr = r & 15, cc = c & 31, ob = rr * 64 + cc * 2; return st * 1024 + (ob ^ (((ob >> 9) & 1) << 5)); }
__host__ __device__ __forceinline__ void stage_rc(int b, int& R, int& C) { const int st = b / 1024, sb = b % 1024, swz = sb ^ (((sb >> 9) & 1) << 5); R = (st >> 1) * 16 + swz / 64; C = (st & 1) * 32 + (swz % 64) / 2; }
__host__ __device__ __forceinline__ int perm32(int rho) { const int n = rho >> 4, i = rho & 15; return 8 * (i >> 2) + 4 * n + (i & 3); }

struct Unit { int pm, pn; };
struct Gemm { const bf16_t* A; const bf16_t* Bt; int M, N, K; };

struct StaticOrder {
    int nM, nN, nwg, G, c;
    __host__ __device__ void init(int M, int N, int G_, int c_) { nM = M / BM; nN = N / BM; nwg = nM * nN; G = G_; c = c_; }
    __host__ __device__ bool next(int i, Unit& u) const {
        const long L = (long)i * G + c; if (L >= nwg) return false;
        int wgid = (int)L; { const int q = nwg / NXCD, r = nwg % NXCD, xcd = wgid % NXCD, off = wgid / NXCD; wgid = (xcd < r ? xcd * (q + 1) : r * (q + 1) + (xcd - r) * q) + off; }
        const int nig = WGM * nN, gid = wgid / nig, fm = gid * WGM, gsz = (nM - fm) < WGM ? (nM - fm) : WGM;
        u.pm = fm + ((wgid % nig) % gsz); u.pn = (wgid % nig) / gsz; return true;
    }
    __device__ __forceinline__ void a_ready(const Unit&) const {}
    __device__ __forceinline__ void done(const Unit&) const {}
};
__device__ __forceinline__ unsigned cvt_pk_bf16(float lo, float hi) { f32x2 v = {lo, hi}; bf16v2_t b = __builtin_convertvector(v, bf16v2_t); return __builtin_bit_cast(unsigned, b); }
template <class Epi, class Sched, bool ALIGN_EPI = false, bool SP2 = false>
__device__ __forceinline__ void gemm_phase(PG8_LAS unsigned char* lds, const Gemm g, const Sched& S, const Epi& E) {
    int tid_ = threadIdx.x; asm volatile("" : "+v"(tid_));
    const int tid = tid_, wid = __builtin_amdgcn_readfirstlane(tid >> 6), lane = tid & 63, wr = wid >> 2, wc = wid & 3, fr = lane & 15, fq = lane >> 4;
    const int K = g.K, nt = K / BK;
    unsigned voffA[2], voffB[2];
#pragma unroll
    for (int i = 0; i < 2; ++i) { int R, C; stage_rc(tid * 16 + i * 8192, R, C); const int Rb = Epi::PERM ? ((R & ~31) + perm32(R & 31)) : R;
        voffA[i] = (unsigned)(R * K + C) * 2u; voffB[i] = (unsigned)(Rb * K + C) * 2u; }
    const size_t kstep = (size_t)(BK * 2);
    const size_t hstep = (size_t)HALF * K * 2;
    const size_t tstep = 2 * hstep;
    const unsigned ldsw = (unsigned)wid * 1024u;
    const int aoff = lds_byte(wr * 64 + fr, fq * 8), boff = lds_byte(wc * 32 + fr, fq * 8);
#define PG8_SA(b, h) (((b) * 2 + (h)) * HTB)
#define PG8_SB(b, h) ((4 + (b) * 2 + (h)) * HTB)
#define PG8_STAGE(bufoff, gbase, voff) do { _Pragma("unroll") for (int _i = 0; _i < 2; ++_i) \
        __builtin_amdgcn_global_load_lds((const unsigned*)((const char*)(gbase) + (voff)[_i]), (PG8_LAS unsigned*)(lds + (bufoff) + ldsw + _i * 8192), 16, 0, 0); } while (0)
#define PG8_LDA(dst, b, h) do { _Pragma("unroll") for (int m = 0; m < 4; ++m) _Pragma("unroll") for (int k = 0; k < 2; ++k) dst[m][k] = *(const PG8_LAS bf16x8*)(lds + PG8_SA(b, h) + aoff + m * 2048 + k * 1024); } while (0)
#define PG8_LDB(dst, b, h) do { _Pragma("unroll") for (int n = 0; n < 2; ++n) _Pragma("unroll") for (int k = 0; k < 2; ++k) dst[n][k] = *(const PG8_LAS bf16x8*)(lds + PG8_SB(b, h) + boff + n * 2048 + k * 1024); } while (0)
#define PG8_MMA(ai, bj, At, Bt) do { __builtin_amdgcn_s_setprio(1); _Pragma("unroll") for (int m = 0; m < 4; ++m) _Pragma("unroll") for (int n = 0; n < 2; ++n) _Pragma("unroll") for (int k = 0; k < 2; ++k) \
        acc[ai][bj][m][n] = __builtin_amdgcn_mfma_f32_16x16x32_bf16(Bt[n][k], At[m][k], acc[ai][bj][m][n], 0, 0, 0); __builtin_amdgcn_s_setprio(0); } while (0)
#define PG8_WAIT_V(n) asm volatile("s_waitcnt vmcnt(" #n ")" ::: "memory")
#define PG8_WAIT_L(n) asm volatile("s_waitcnt lgkmcnt(" #n ")" ::: "memory")
#define PG8_BAR __builtin_amdgcn_s_barrier()
#define PG8_SCHED __builtin_amdgcn_sched_barrier(0)
    Unit cur, nxt; int ui = 0;
    if (!S.next(0, cur)) return;
    f32x4 acc[2][2][4][2];
#pragma unroll
    for (int a = 0; a < 2; ++a)
#pragma unroll
        for (int b = 0; b < 2; ++b)
#pragma unroll
            for (int m = 0; m < 4; ++m)
#pragma unroll
                for (int n = 0; n < 2; ++n) acc[a][b][m][n] = (f32x4){0.f, 0.f, 0.f, 0.f};
    bf16x8 At[4][2], B0[2][2], B1[2][2];
    const char* cA = (const char*)g.A + (size_t)cur.pm * tstep; const char* cB = (const char*)g.Bt + (size_t)cur.pn * tstep;
    S.a_ready(cur);
    if constexpr (SP2) {
        PG8_STAGE(PG8_SB(0, 0), cB, voffB); PG8_STAGE(PG8_SB(0, 1), cB + hstep, voffB); PG8_STAGE(PG8_SA(0, 0), cA, voffA); PG8_STAGE(PG8_SA(0, 1), cA + hstep, voffA);
        if (wr == 1) PG8_BAR;
        PG8_WAIT_V(2); PG8_BAR;
        PG8_STAGE(PG8_SB(1, 0), cB + kstep, voffB); PG8_STAGE(PG8_SA(1, 0), cA + kstep, voffA); PG8_STAGE(PG8_SB(1, 1), cB + hstep + kstep, voffB);
        PG8_WAIT_V(6); PG8_BAR;
    } else {
        PG8_STAGE(PG8_SB(0, 0), cB, voffB); PG8_STAGE(PG8_SA(0, 0), cA, voffA); PG8_STAGE(PG8_SB(0, 1), cB + hstep, voffB); PG8_STAGE(PG8_SA(0, 1), cA + hstep, voffA);
        if (wr == 1) PG8_BAR;
        PG8_WAIT_V(4); PG8_BAR;
        PG8_STAGE(PG8_SB(1, 0), cB + kstep, voffB); PG8_STAGE(PG8_SA(1, 0), cA + kstep, voffA); PG8_STAGE(PG8_SB(1, 1), cB + hstep + kstep, voffB);
        PG8_WAIT_V(6); PG8_BAR;
    }
    for (;;) {
        const bool has_next = S.next(ui + 1, nxt);
        const char* nA = has_next ? (const char*)g.A + (size_t)nxt.pm * tstep : cA; const char* nB = has_next ? (const char*)g.Bt + (size_t)nxt.pn * tstep : cB;
#pragma clang loop unroll(disable)
        for (int t = 0; t < nt; t += 2) {
            const bool last = (t == nt - 2);
            const char* a1 = cA + (size_t)(t + 1) * kstep;
            const char* a2 = last ? nA : cA + (size_t)(t + 2) * kstep; const char* b2 = last ? nB : cB + (size_t)(t + 2) * kstep;
            const char* a3 = a2 + kstep; const char* b3 = b2 + kstep;
            if (last && has_next) S.a_ready(nxt);
            if constexpr (SP2) {
            PG8_LDB(B0, 0, 0); PG8_LDB(B1, 0, 1); PG8_SCHED; PG8_LDA(At, 0, 0); PG8_STAGE(PG8_SA(1, 1), a1 + hstep, voffA);
            PG8_WAIT_V(8); PG8_WAIT_L(0); PG8_BAR; PG8_MMA(0, 0, At, B0); PG8_MMA(0, 1, At, B1); PG8_BAR; PG8_SCHED;
            PG8_LDA(At, 0, 1); PG8_STAGE(PG8_SB(0, 0), b2, voffB); PG8_STAGE(PG8_SB(0, 1), b2 + hstep, voffB); PG8_STAGE(PG8_SA(0, 0), a2, voffA);
            PG8_WAIT_V(8); PG8_WAIT_L(0); PG8_BAR; PG8_MMA(1, 0, At, B0); PG8_MMA(1, 1, At, B1); PG8_BAR; PG8_SCHED;
            PG8_LDB(B0, 1, 0); PG8_LDB(B1, 1, 1); PG8_SCHED; PG8_LDA(At, 1, 0); PG8_STAGE(PG8_SA(0, 1), a2 + hstep, voffA);
            PG8_WAIT_V(8); PG8_WAIT_L(0); PG8_BAR; PG8_MMA(0, 0, At, B0); PG8_MMA(0, 1, At, B1); PG8_BAR; PG8_SCHED;
            PG8_LDA(At, 1, 1); PG8_STAGE(PG8_SB(1, 0), b3, voffB); PG8_STAGE(PG8_SB(1, 1), b3 + hstep, voffB); PG8_STAGE(PG8_SA(1, 0), a3, voffA);
            PG8_WAIT_V(8); PG8_WAIT_L(0); PG8_BAR; PG8_MMA(1, 0, At, B0); PG8_MMA(1, 1, At, B1); PG8_BAR; PG8_SCHED;
            } else {
            PG8_LDB(B0, 0, 0); PG8_SCHED; PG8_LDA(At, 0, 0); PG8_STAGE(PG8_SA(1, 1), a1 + hstep, voffA);
            PG8_WAIT_L(8); PG8_BAR; PG8_WAIT_L(0); PG8_MMA(0, 0, At, B0); PG8_BAR; PG8_SCHED;
            PG8_LDB(B1, 0, 1); PG8_STAGE(PG8_SB(0, 0), b2, voffB);
            PG8_BAR; PG8_WAIT_L(0); PG8_MMA(0, 1, At, B1); PG8_BAR;
            PG8_LDA(At, 0, 1); PG8_STAGE(PG8_SA(0, 0), a2, voffA);
            PG8_BAR; PG8_WAIT_L(0); PG8_MMA(1, 0, At, B0); PG8_BAR; PG8_SCHED;
            PG8_STAGE(PG8_SB(0, 1), b2 + hstep, voffB);
            PG8_WAIT_V(6); PG8_BAR; PG8_MMA(1, 1, At, B1); PG8_BAR;
            PG8_LDB(B0, 1, 0); PG8_SCHED; PG8_LDA(At, 1, 0); PG8_STAGE(PG8_SA(0, 1), a2 + hstep, voffA);
            PG8_WAIT_L(8); PG8_BAR; PG8_WAIT_L(0); PG8_MMA(0, 0, At, B0); PG8_BAR; PG8_SCHED;
            PG8_LDB(B1, 1, 1); PG8_STAGE(PG8_SB(1, 0), b3, voffB);
            PG8_BAR; PG8_WAIT_L(0); PG8_MMA(0, 1, At, B1); PG8_BAR;
            PG8_LDA(At, 1, 1); PG8_STAGE(PG8_SA(1, 0), a3, voffA);
            PG8_BAR; PG8_WAIT_L(0); PG8_MMA(1, 0, At, B0); PG8_BAR; PG8_SCHED;
            PG8_STAGE(PG8_SB(1, 1), b3 + hstep, voffB);
            PG8_WAIT_V(6); PG8_BAR; PG8_MMA(1, 1, At, B1); PG8_BAR;
            }
        }
        if constexpr (ALIGN_EPI) { if (wr == 0) PG8_BAR; }
        if constexpr (!Epi::AFTER_DRAIN) { E(acc, cur, wr, wc, fr, fq); S.done(cur); }
        if (!has_next) break;
#pragma unroll
        for (int a = 0; a < 2; ++a)
#pragma unroll
            for (int b = 0; b < 2; ++b)
#pragma unroll
                for (int m = 0; m < 4; ++m)
#pragma unroll
                    for (int n = 0; n < 2; ++n) acc[a][b][m][n] = (f32x4){0.f, 0.f, 0.f, 0.f};
        cur = nxt; cA = nA; cB = nB; ++ui;
        if constexpr (ALIGN_EPI) { if (wr == 1) PG8_BAR; }
    }
    PG8_WAIT_V(0);
    if constexpr (!ALIGN_EPI) { if (wr == 0) PG8_BAR; }
    PG8_BAR;
    if constexpr (Epi::AFTER_DRAIN) { E.fused(acc, cur, wr, wc, fr, fq, lds, wid, lane); S.done(cur); }
#undef PG8_SA
#undef PG8_SB
#undef PG8_STAGE
#undef PG8_LDA
#undef PG8_LDB
#undef PG8_MMA
#undef PG8_WAIT_V
#undef PG8_WAIT_L
#undef PG8_BAR
#undef PG8_SCHED
}

#define EPI_ROWS(...) _Pragma("unroll") for (int ai = 0; ai < 2; ++ai) _Pragma("unroll") for (int m = 0; m < 4; ++m) { const int row = row0 + ai * HALF + m * 16; __VA_ARGS__ }
__device__ __forceinline__ u32x4 pack8(const f32x4& v0, const f32x4& v1) { u32x4 w; w.x = cvt_pk_bf16(v0[0], v0[1]); w.y = cvt_pk_bf16(v0[2], v0[3]); w.z = cvt_pk_bf16(v1[0], v1[1]); w.w = cvt_pk_bf16(v1[2], v1[3]); return w; }
__device__ __forceinline__ void rope8(f32x4& v0, f32x4& v1, const f32x4& cs0, const f32x4& cs1) {
    const f32x4 a = v0, b = v1;
    v0[0] = a[0] * cs0[0] - a[1] * cs0[1]; v0[1] = a[1] * cs0[0] + a[0] * cs0[1]; v0[2] = a[2] * cs0[2] - a[3] * cs0[3]; v0[3] = a[3] * cs0[2] + a[2] * cs0[3];
    v1[0] = b[0] * cs1[0] - b[1] * cs1[1]; v1[1] = b[1] * cs1[0] + b[0] * cs1[1]; v1[2] = b[2] * cs1[2] - b[3] * cs1[3]; v1[3] = b[3] * cs1[2] + b[2] * cs1[3];
}
struct EpiWin {
    static constexpr bool PERM = true, AFTER_DRAIN = false;
    bf16_t *RNN, *RET, *GATES; float* MLAR; const float* TABR;
    __device__ __forceinline__ void operator()(const f32x4 (&acc)[2][2][4][2], const Unit& u, int wr, int wc, int fr, int fq) const {
        const int row0 = u.pm * BM + wr * 64 + fr; const int cw = wc * 32 + 8 * fq;
        if (u.pn >= 48) { const int col0 = (u.pn - 48) * BM + cw;
            EPI_ROWS( float* rp = MLAR + (size_t)row * 1024 + col0;
                _Pragma("unroll") for (int bj = 0; bj < 2; ++bj) { *(f32x4*)(rp + bj * HALF) = acc[ai][bj][m][0]; *(f32x4*)(rp + bj * HALF + 4) = acc[ai][bj][m][1]; } )
        } else if (u.pn >= 24) { const int col0 = (u.pn - 24) * BM + cw;
            EPI_ROWS( bf16_t* rp = GATES + (size_t)row * 6144 + col0;
                _Pragma("unroll") for (int bj = 0; bj < 2; ++bj) { f32x4 v0 = acc[ai][bj][m][0], v1 = acc[ai][bj][m][1];
                    _Pragma("unroll") for (int j = 0; j < 4; ++j) { v0[j] = __builtin_amdgcn_rcpf(1.0f + __builtin_amdgcn_exp2f(-1.4426950408889634f * v0[j])); v1[j] = __builtin_amdgcn_rcpf(1.0f + __builtin_amdgcn_exp2f(-1.4426950408889634f * v1[j])); }
                    *(u32x4*)(rp + bj * HALF) = pack8(v0, v1); } )
        } else if (u.pn >= 8) { const int col0 = (u.pn - 8) * BM + cw; const bool rot = (u.pn < 16) && (u.pm >= 16);
            const int wd = cw & 127, blk = wd >> 6, i0 = (wd & 63) >> 1;
            EPI_ROWS( bf16_t* rp = RET + (size_t)row * 4096 + col0;
                f32x4 cs0 = {1.f, 0.f, 1.f, 0.f}, cs1 = {1.f, 0.f, 1.f, 0.f};
                if (rot) { const int t = (row - 4096) & 1023; const int pos = blk ? (t & 63) : (t >> 6); const f32x4* tp = (const f32x4*)(TABR + ((size_t)pos * 32 + i0) * 2); cs0 = tp[0]; cs1 = tp[1]; }
                _Pragma("unroll") for (int bj = 0; bj < 2; ++bj) { f32x4 v0 = acc[ai][bj][m][0], v1 = acc[ai][bj][m][1]; if (rot) rope8(v0, v1, cs0, cs1); *(u32x4*)(rp + bj * HALF) = pack8(v0, v1); } )
        } else { const int col0 = u.pn * BM + cw;
            EPI_ROWS( bf16_t* rp = RNN + (size_t)row * 2048 + col0;
                _Pragma("unroll") for (int bj = 0; bj < 2; ++bj) *(u32x4*)(rp + bj * HALF) = pack8(acc[ai][bj][m][0], acc[ai][bj][m][1]); )
        }
    }
};
struct EpiQup {
    static constexpr bool PERM = true, AFTER_DRAIN = false;
    bf16_t* Q; const float* TABM;
    __device__ __forceinline__ void operator()(const f32x4 (&acc)[2][2][4][2], const Unit& u, int wr, int wc, int fr, int fq) const {
        const int row0 = u.pm * BM + wr * 64 + fr; const int col0 = u.pn * BM + wc * 32 + 8 * fq; const bool lat = u.pm >= 16;
        EPI_ROWS( bf16_t* rp = Q + (size_t)row * 1536 + col0; const int t = (row - 4096) & 1023;
            _Pragma("unroll") for (int bj = 0; bj < 2; ++bj) { f32x4 v0 = acc[ai][bj][m][0], v1 = acc[ai][bj][m][1]; const int c = col0 + bj * HALF; const int r = c % 192;
                if (lat && r >= 128) { const int wd = r - 128, blk = wd >> 5, i0 = (wd & 31) >> 1; const int pos = blk ? (t & 63) : (t >> 6); const f32x4* tp = (const f32x4*)(TABM + ((size_t)pos * 16 + i0) * 2); rope8(v0, v1, tp[0], tp[1]); }
                *(u32x4*)(rp + bj * HALF) = pack8(v0, v1); } )
    }
};
struct EpiSplit {
    static constexpr bool PERM = true, AFTER_DRAIN = false;
    bf16_t *O0, *O1; int ldc, nsplit;
    __device__ __forceinline__ void operator()(const f32x4 (&acc)[2][2][4][2], const Unit& u, int wr, int wc, int fr, int fq) const {
        const int row0 = u.pm * BM + wr * 64 + fr; bf16_t* base = u.pn < nsplit ? O0 : O1; const int col0 = (u.pn < nsplit ? u.pn : u.pn - nsplit) * BM + wc * 32 + 8 * fq;
        EPI_ROWS( bf16_t* rp = base + (size_t)row * ldc + col0;
            _Pragma("unroll") for (int bj = 0; bj < 2; ++bj) *(u32x4*)(rp + bj * HALF) = pack8(acc[ai][bj][m][0], acc[ai][bj][m][1]); )
    }
};
struct EpiRelu2 {
    static constexpr bool PERM = true, AFTER_DRAIN = false;
    bf16_t* O; int ldc;
    __device__ __forceinline__ void operator()(const f32x4 (&acc)[2][2][4][2], const Unit& u, int wr, int wc, int fr, int fq) const {
        const int row0 = u.pm * BM + wr * 64 + fr; const int col0 = u.pn * BM + wc * 32 + 8 * fq;
        EPI_ROWS( bf16_t* rp = O + (size_t)row * ldc + col0;
            _Pragma("unroll") for (int bj = 0; bj < 2; ++bj) { f32x4 v0 = acc[ai][bj][m][0], v1 = acc[ai][bj][m][1];
                _Pragma("unroll") for (int j = 0; j < 4; ++j) { const float a = fmaxf(v0[j], 0.f), b = fmaxf(v1[j], 0.f); v0[j] = a * a; v1[j] = b * b; }
                *(u32x4*)(rp + bj * HALF) = pack8(v0, v1); } )
    }
};
struct EpiF32 {
    static constexpr bool PERM = true, AFTER_DRAIN = false;
    float* C; int ldc;
    __device__ __forceinline__ void operator()(const f32x4 (&acc)[2][2][4][2], const Unit& u, int wr, int wc, int fr, int fq) const {
        const int row0 = u.pm * BM + wr * 64 + fr; const int col0 = u.pn * BM + wc * 32 + 8 * fq;
        EPI_ROWS( float* rp = C + (size_t)row * ldc + col0;
            _Pragma("unroll") for (int bj = 0; bj < 2; ++bj) { *(f32x4*)(rp + bj * HALF) = acc[ai][bj][m][0]; *(f32x4*)(rp + bj * HALF + 4) = acc[ai][bj][m][1]; } )
    }
};
struct EpiBranch {
    static constexpr bool PERM = true, AFTER_DRAIN = false;
    const bf16_t* G; float* TMP; bf16_t* MERGED;
    __device__ __forceinline__ void operator()(const f32x4 (&acc)[2][2][4][2], const Unit& u, int wr, int wc, int fr, int fq) const {
        const int br = u.pm >> 5, pm = u.pm & 31, pn = u.pn & 7; const int row0 = pm * BM + wr * 64 + fr; const int col0 = pn * BM + wc * 32 + 8 * fq;
        EPI_ROWS( const bf16_t* gp = G + (size_t)row * 6144 + br * 2048 + col0; float* tp = TMP + (size_t)row * 2048 + col0; bf16_t* mp = MERGED + (size_t)row * 2048 + col0;
            _Pragma("unroll") for (int bj = 0; bj < 2; ++bj) { const u32x4 gw = *(const u32x4*)(gp + bj * HALF);
                f32x4 g0 = {__uint_as_float(gw.x << 16), __uint_as_float(gw.x & 0xffff0000u), __uint_as_float(gw.y << 16), __uint_as_float(gw.y & 0xffff0000u)};
                f32x4 g1 = {__uint_as_float(gw.z << 16), __uint_as_float(gw.z & 0xffff0000u), __uint_as_float(gw.w << 16), __uint_as_float(gw.w & 0xffff0000u)};
                f32x4 v0 = acc[ai][bj][m][0] * g0, v1 = acc[ai][bj][m][1] * g1;
                if (br > 0) { v0 += *(const f32x4*)(tp + bj * HALF); v1 += *(const f32x4*)(tp + bj * HALF + 4); }
                if (br < 2) { *(f32x4*)(tp + bj * HALF) = v0; *(f32x4*)(tp + bj * HALF + 4) = v1; }
                else *(u32x4*)(mp + bj * HALF) = pack8(v0, v1); } )
    }
};
struct BranchOrder {
    StaticOrder S0;
    __device__ void init(int G, int c) { S0.init(8192, 2048, G, c); }
    __device__ bool next(int i, Unit& u) const { Unit b; if (!S0.next(i / 3, b)) return false; const int br = i % 3; u.pm = br * 32 + b.pm; u.pn = br * 8 + b.pn; return true; }
    __device__ __forceinline__ void a_ready(const Unit&) const {}
    __device__ __forceinline__ void done(const Unit&) const {}
};
#undef EPI_ROWS
}

namespace fx {
struct Ctx {
    LAS unsigned char* lds; int tid, lane, wave, G, c;
};
#define WG_SYNC() __syncthreads()

__device__ __forceinline__ int maprow(int map, int n) {
    if (map == 1) {
        if (n < 2048) return n;
        if (n < 2880) return n + 10240;
        int nn = n - 832;
        if (n < 4928) { const int d = (n - 2880) & 127; nn = nn - d + ret_new_of_old(d); }
        return nn;
    }
    if (map == 2) { const int h = n / 192, j = n % 192; return j < 128 ? n : h * 192 + 128 + mla_new_of_old(j - 128); }
    if (map == 3) { const int h = n >> 8, j = n & 255; return j < 128 ? h * 128 + j : 1024 + h * 128 + (j - 128); }
    return n;
}
__device__ __forceinline__ void transpose_tile(const float* __restrict__ W, int N, bf16_t* __restrict__ WT, int ldt, int map, int k0, int n0, LAS float* scr, int lane) {
    const int rr = lane >> 4, c4 = (lane & 15) * 4;
#pragma unroll 4
    for (int i = 0; i < 16; ++i) { const int row = 4 * i + rr; const f32x4 v = *(const f32x4*)(W + (size_t)(k0 + row) * N + n0 + c4);
        LAS float* s = scr + row * 65 + c4; s[0] = v[0]; s[1] = v[1]; s[2] = v[2]; s[3] = v[3]; }
    asm volatile("s_waitcnt lgkmcnt(0)" ::: "memory");
    const int kc = lane & 7;
#pragma unroll
    for (int j = 0; j < 8; ++j) { const int n = (lane >> 3) + 8 * j; const LAS float* s = scr + (8 * kc) * 65 + n;
        u32x4 o; o.x = pk2(s[0], s[65]); o.y = pk2(s[2 * 65], s[3 * 65]); o.z = pk2(s[4 * 65], s[5 * 65]); o.w = pk2(s[6 * 65], s[7 * 65]);
        *(u32x4*)(WT + (size_t)maprow(map, n0 + n) * ldt + k0 + 8 * kc) = o; }
    asm volatile("s_waitcnt lgkmcnt(0)" ::: "memory");
}
constexpr int TI_WIN = 32 * 205, TI_WUQ = 8 * 24, TI_WUKV = 4 * 32, TI_WBR = 16 * 32, TI_WOUT = 32 * 32, TI_W1 = 32 * 128, TI_W2 = 128 * 32, TI_LRU = 32 * 4;
constexpr int TI_LAYER = TI_WIN + TI_WUQ + TI_WUKV + 3 * TI_WBR + TI_WOUT + TI_W1 + TI_W2 + TI_LRU;
__device__ __forceinline__ void convert_weights(const Ctx& X, const P& p) {
    LAS float* scr = (LAS float*)(X.lds) + X.wave * (64 * 65);
    const int gw = X.c * NWAVES + X.wave, NGW = X.G * NWAVES; const int nl = p.l_hi - p.l_lo;
    for (int it = gw; it < nl * TI_LAYER; it += NGW) {
        const int l = p.l_lo + it / TI_LAYER; int r = it % TI_LAYER; unsigned char* wl = p.ws + WS_W + (size_t)l * WL_STRIDE;
        if (r < TI_WIN) { transpose_tile(p.in[11] + (size_t)l * 2048 * 13120, 13120, (bf16_t*)(wl + WO_WIN), 2048, 1, (r / 205) * 64, (r % 205) * 64, scr, X.lane); continue; } r -= TI_WIN;
        if (r < TI_WUQ) { transpose_tile(p.in[21] + (size_t)l * 512 * 1536, 1536, (bf16_t*)(wl + WO_WUQ), 512, 2, (r / 24) * 64, (r % 24) * 64, scr, X.lane); continue; } r -= TI_WUQ;
        if (r < TI_WUKV) { transpose_tile(p.in[22] + (size_t)l * 256 * 2048, 2048, (bf16_t*)(wl + WO_WUKV), 256, 3, (r / 32) * 64, (r % 32) * 64, scr, X.lane); continue; } r -= TI_WUKV;
        if (r < 3 * TI_WBR) { const int br = r / TI_WBR, q = r % TI_WBR; transpose_tile(p.in[24 + br] + (size_t)l * 1024 * 2048, 2048, (bf16_t*)(wl + WO_WBR) + (size_t)br * 2048 * 1024, 1024, 0, (q / 32) * 64, (q % 32) * 64, scr, X.lane); continue; } r -= 3 * TI_WBR;
        if (r < TI_WOUT) { transpose_tile(p.in[27] + (size_t)l * 2048 * 2048, 2048, (bf16_t*)(wl + WO_WOUT), 2048, 0, (r / 32) * 64, (r % 32) * 64, scr, X.lane); continue; } r -= TI_WOUT;
        if (r < TI_W1) { transpose_tile(p.in[28] + (size_t)l * 2048 * 8192, 8192, (bf16_t*)(wl + WO_W1), 2048, 0, (r / 128) * 64, (r % 128) * 64, scr, X.lane); continue; } r -= TI_W1;
        if (r < TI_W2) { transpose_tile(p.in[29] + (size_t)l * 8192 * 2048, 2048, (bf16_t*)(wl + WO_W2), 8192, 0, (r / 32) * 64, (r % 32) * 64, scr, X.lane); continue; } r -= TI_W2;
        { const int mat = r >> 2, q = r & 3; const int gate = mat & 1, blk = (mat >> 1) & 7, dir = mat >> 4;
          const float* src = p.in[gate ? 16 : 14] + ((((size_t)l * 2 + dir) * 8 + blk) * 128) * 128;
          transpose_tile(src, 128, (bf16_t*)(wl + WO_LRUW) + ((((size_t)dir * 8 + blk) * 2 + gate) * 128) * 128, 128, 0, (q >> 1) * 64, (q & 1) * 64, scr, X.lane); }
    }
    for (int l = p.l_lo; l < p.l_hi; ++l) { u32x4* z = (u32x4*)((bf16_t*)(p.ws + WS_W + (size_t)l * WL_STRIDE + WO_WIN) + (size_t)13120 * 2048);
        for (int i = X.c * NTHR + X.tid; i < 192 * 2048 / 8; i += X.G * NTHR) z[i] = (u32x4){0u, 0u, 0u, 0u}; }
}
__device__ __forceinline__ void ada_partials(const Ctx& X, const P& p) {
    LAS float* sl = (LAS float*)X.lds;
    LAS float* red = sl + 5 * 512;
    float* ADAP = (float*)(p.ws + WS_ADAP); const int nl = p.l_hi - p.l_lo;
    for (int it = X.c; it < nl * 48 * 4; it += X.G) {
        const int l = p.l_lo + it / 192, q = it % 192, nb = q >> 2, ks = q & 3;
        WG_SYNC();
#pragma unroll
        for (int ci = 0; ci < 5; ++ci) { const float* cond = ci ? p.in[2] + (size_t)(ci - 1) * D : p.in[7]; const float v = cond[ks * 512 + X.tid]; sl[ci * 512 + X.tid] = v * fsigm(v); }
        WG_SYNC();
        const float* W = p.in[8] + ((size_t)l * D + ks * 512 + X.wave * 64) * NADA + nb * 256 + 4 * X.lane;
        f32x4 a0 = {0.f, 0.f, 0.f, 0.f}, a1 = a0, a2 = a0, a3 = a0, a4 = a0;
#pragma unroll 8
        for (int kk = 0; kk < 64; ++kk) { const f32x4 w = *(const f32x4*)(W + (size_t)kk * NADA); const int k = X.wave * 64 + kk;
            a0 += w * sl[k]; a1 += w * sl[512 + k]; a2 += w * sl[1024 + k]; a3 += w * sl[1536 + k]; a4 += w * sl[2048 + k]; }
        LAS float* rw = red + X.wave * (20 * 64) + X.lane;
#pragma unroll
        for (int j = 0; j < 4; ++j) { rw[(0 + j) * 64] = a0[j]; rw[(4 + j) * 64] = a1[j]; rw[(8 + j) * 64] = a2[j]; rw[(12 + j) * 64] = a3[j]; rw[(16 + j) * 64] = a4[j]; }
        WG_SYNC();
        for (int e = X.tid; e < 20 * 64; e += NTHR) { float s = 0.f;
#pragma unroll
            for (int w = 0; w < 8; ++w) s += red[w * (20 * 64) + e];
            const int ci = e / 256, j = (e >> 6) & 3, ln = e & 63;
            ADAP[(((size_t)ks * NL + l) * NCOND + ci) * NADA + nb * 256 + 4 * ln + j] = s; }
    }
    WG_SYNC();
}
__device__ __forceinline__ void make_tables(const Ctx& X, const P& p) {
    float* TR = (float*)(p.ws + WS_TABR); float* TM = (float*)(p.ws + WS_TABM);
    for (int e = X.c * NTHR + X.tid; e < 64 * 32 + 64 * 16; e += X.G * NTHR) {
        if (e < 2048) { const int pos = e >> 5, i = e & 31; const float ang = (float)pos * powf(10000.0f, -(float)(2 * i) / 64.0f); TR[2 * e] = cosf(ang); TR[2 * e + 1] = sinf(ang); }
        else { const int f = e - 2048, pos = f >> 4, i = f & 15; const float ang = (float)pos * powf(10000.0f, -(float)(2 * i) / 32.0f); TM[2 * f] = cosf(ang); TM[2 * f + 1] = sinf(ang); }
    }
}
__device__ __forceinline__ void ada_reduce(const Ctx& X, const P& p) {
    const float* ADAP = (const float*)(p.ws + WS_ADAP); float* ADA = (float*)(p.ws + WS_ADA); const int nl = p.l_hi - p.l_lo;
    for (int e = X.c * NTHR + X.tid; e < nl * NCOND * NADA; e += X.G * NTHR) { const int l = p.l_lo + e / (NCOND * NADA), q = e % (NCOND * NADA), n = q % NADA; const size_t idx = (size_t)l * NCOND * NADA + q;
        float s = p.in[9][(size_t)l * NADA + n];
#pragma unroll
        for (int ks = 0; ks < 4; ++ks) s += ADAP[(size_t)ks * NL * NCOND * NADA + idx];
        ADA[idx] = s; }
}
template <int MODE> __device__ __forceinline__ void rowwise(const Ctx& X, const P& p, int l) {
    const float* ADA = (const float*)(p.ws + WS_ADA); const float* U = (const float*)(p.ws + WS_U); bf16_t* H = (bf16_t*)(p.ws + WS_H); const float* gn = p.in[10];
    const int gw = X.c * NWAVES + X.wave, NGW = X.G * NWAVES;
    for (int m = gw; m < NTOK; m += NGW) {
        const int ci = cond_of(m); f32x4 x[8]; float* xr = p.xres + (size_t)m * D;
        if (MODE == 0) { const float* src = l > 0 ? xr : (m < NCTX ? p.in[0] + (size_t)m * D : p.in[1] + (size_t)(m - NCTX) * D);
#pragma unroll
            for (int j = 0; j < 8; ++j) { x[j] = *(const f32x4*)(src + 256 * j + 4 * X.lane); if (l == 0) *(f32x4*)(xr + 256 * j + 4 * X.lane) = x[j]; } }
        else {
            const float* ur = U + (size_t)m * D; f32x4 u[8]; float ss = 0.f;
#pragma unroll
            for (int j = 0; j < 8; ++j) { u[j] = *(const f32x4*)(ur + 256 * j + 4 * X.lane); ss += (u[j][0] * u[j][0] + u[j][1] * u[j][1]) + (u[j][2] * u[j][2] + u[j][3] * u[j][3]); }
            const float rs = 1.0f / sqrtf(wave_sum(ss) * (1.0f / D) + 1e-6f);
            const float* g = gn + ((size_t)l * 4 + (MODE == 1 ? 1 : 3)) * D; const float* ga = ADA + ((size_t)l * NCOND + ci) * NADA + (MODE == 1 ? 2 : 5) * D;
#pragma unroll
            for (int j = 0; j < 8; ++j) { const int c = 256 * j + 4 * X.lane; const f32x4 gv = *(const f32x4*)(g + c), gav = *(const f32x4*)(ga + c); x[j] = *(const f32x4*)(xr + c) + gav * (u[j] * rs * gv); *(f32x4*)(xr + c) = x[j]; }
        }
        const int ln = (MODE == 2) ? l + 1 : l;
        if (MODE != 2 || ln < NL) {
            float ss = 0.f;
#pragma unroll
            for (int j = 0; j < 8; ++j) ss += (x[j][0] * x[j][0] + x[j][1] * x[j][1]) + (x[j][2] * x[j][2] + x[j][3] * x[j][3]);
            const float rs = 1.0f / sqrtf(wave_sum(ss) * (1.0f / D) + 1e-6f);
            const float* g = gn + ((size_t)ln * 4 + (MODE == 1 ? 2 : 0)) * D; const float* a = ADA + ((size_t)ln * NCOND + ci) * NADA; const float* sh = a + (MODE == 1 ? 3 : 0) * D; const float* sc = a + (MODE == 1 ? 4 : 1) * D;
            bf16_t* hr = H + (size_t)m * D;
#pragma unroll
            for (int j = 0; j < 8; ++j) { const int c = 256 * j + 4 * X.lane; const f32x4 gv = *(const f32x4*)(g + c), shv = *(const f32x4*)(sh + c), scv = *(const f32x4*)(sc + c);
                const f32x4 h = (x[j] * rs * gv) * (scv + 1.0f) + shv; u32x2 w; w.x = pk2(h[0], h[1]); w.y = pk2(h[2], h[3]); *(u32x2*)(hr + c) = w; }
        }
    }
}
__device__ __forceinline__ float gelu_tanh_f(float x) { const float u = 0.7978845608028654f * (x + 0.044715f * x * x * x); const float e = __expf(2.0f * u); return 0.5f * x * (1.0f + (1.0f - 2.0f / (e + 1.0f))); }
__device__ __forceinline__ void lru_gates(const Ctx& X, const P& p, int l) {
    constexpr int XB_STR = 136;
    LAS bf16_t* XCB = (LAS bf16_t*)X.lds;
    LAS float* XCF = (LAS float*)(X.lds + 64 * XB_STR * 2);
    const bf16_t* RNN = (const bf16_t*)(p.ws + WS_RNN); float* LA = (float*)(p.ws + WS_LA); float* LB = (float*)(p.ws + WS_LB);
    const bf16_t* LW = (const bf16_t*)(p.ws + WS_W + (size_t)l * WL_STRIDE + WO_LRUW);
    const int fr = X.lane & 15, fg = X.lane >> 4;
    for (int cb = X.c; cb < 256; cb += X.G) {
        const int combo = cb >> 4, dir = combo >> 3, blk = combo & 7;
        bf16x8 bw[2][4];
#pragma unroll
        for (int g = 0; g < 2; ++g)
#pragma unroll
            for (int kk = 0; kk < 4; ++kk) bw[g][kk] = *(const bf16x8*)(LW + ((((size_t)dir * 8 + blk) * 2 + g) * 128 + 16 * X.wave + fr) * 128 + 32 * kk + 8 * fg);
        const int ch = blk * 128 + 16 * X.wave + fr; const size_t po = ((size_t)l * 2 + dir) * DR + ch;
        const float ba = p.in[15][po], bx = p.in[17][po], lam = p.in[18][po]; const float sp = fmaxf(-lam, 0.f) + log1pf(__expf(-fabsf(lam)));
        for (int i = 0; i < 8; ++i) {
            const int tt = (cb & 15) + 16 * i, m0 = tt * 64;
            const int T = m0 < NCTX ? 256 : 1024; const int tb = (m0 < NCTX ? m0 : m0 - NCTX) & (T - 1);
            WG_SYNC();
            {
                const int r = X.tid >> 3, cg = (X.tid & 7) * 16; const int t = tb + r; float acc[16];
                const float* cbp = p.in[13] + ((size_t)l * 2 + dir) * DR + blk * 128 + cg;
#pragma unroll
                for (int e = 0; e < 16; ++e) acc[e] = cbp[e];
#pragma unroll
                for (int j = 0; j < 4; ++j) { const int dt = dir ? 3 - j : j - 3; const int t2 = t + dt;
                    if (t2 >= 0 && t2 < T) { const bf16_t* xp = RNN + (size_t)(m0 + r + dt) * 2048 + blk * 128 + cg; const u32x4 x0 = *(const u32x4*)xp, x1 = *(const u32x4*)(xp + 8);
                        const float* wp = p.in[12] + (((size_t)l * 2 + dir) * 4 + j) * DR + blk * 128 + cg;
                        const unsigned xw[8] = {x0.x, x0.y, x0.z, x0.w, x1.x, x1.y, x1.z, x1.w};
#pragma unroll
                        for (int e = 0; e < 8; ++e) { acc[2 * e] += wp[2 * e] * lo_bf(xw[e]); acc[2 * e + 1] += wp[2 * e + 1] * hi_bf(xw[e]); } } }
#pragma unroll
                for (int e = 0; e < 16; ++e) XCF[r * 129 + cg + e] = acc[e];
                u32x4 o0, o1; o0.x = pk2(acc[0], acc[1]); o0.y = pk2(acc[2], acc[3]); o0.z = pk2(acc[4], acc[5]); o0.w = pk2(acc[6], acc[7]); o1.x = pk2(acc[8], acc[9]); o1.y = pk2(acc[10], acc[11]); o1.z = pk2(acc[12], acc[13]); o1.w = pk2(acc[14], acc[15]);
                *(LAS u32x4*)(XCB + r * XB_STR + cg) = o0; *(LAS u32x4*)(XCB + r * XB_STR + cg + 8) = o1;
            }
            WG_SYNC();
#pragma unroll
            for (int mb = 0; mb < 4; ++mb) {
                f32x4 ca = {0.f, 0.f, 0.f, 0.f}, cx = ca;
#pragma unroll
                for (int kk = 0; kk < 4; ++kk) { const bf16x8 a = *(const LAS bf16x8*)(XCB + (16 * mb + fr) * XB_STR + 32 * kk + 8 * fg);
                    ca = __builtin_amdgcn_mfma_f32_16x16x32_bf16(a, bw[0][kk], ca, 0, 0, 0); cx = __builtin_amdgcn_mfma_f32_16x16x32_bf16(a, bw[1][kk], cx, 0, 0, 0); }
#pragma unroll
                for (int rg = 0; rg < 4; ++rg) { const int r = 16 * mb + 4 * fg + rg;
                    const float rgate = fsigm(ca[rg] + ba), igate = fsigm(cx[rg] + bx); const float log_a = -8.0f * rgate * sp; const float xcv = XCF[r * 129 + 16 * X.wave + fr];
                    const size_t o = ((size_t)dir * NTOK + m0 + r) * DR + ch; LA[o] = __expf(log_a); LB[o] = sqrtf(-expm1f(2.0f * log_a)) * (igate * xcv); }
            }
        }
    }
    WG_SYNC();
}
__device__ __forceinline__ void lru_scan_item(const Ctx& X, const P& p, int l, int lat, int b, int cg) {
    const int T = lat ? 1024 : 256, mseq = lat ? NCTX + b * 1024 : b * 256; const int ch = cg * 64 + X.lane, seg = X.wave;
    const float* LA = (const float*)(p.ws + WS_LA); const float* LB = (const float*)(p.ws + WS_LB); float* HSF = (float*)(p.ws + WS_HSF);
    const bf16_t* RNN = (const bf16_t*)(p.ws + WS_RNN); bf16_t* YL = (bf16_t*)(p.ws + WS_YCAT);
    LAS f32x2* AB = (LAS f32x2*)X.lds;
    int buf = 0;
#pragma unroll 1
    for (int dir = 0; dir < 2; ++dir) {
        float carry = lat ? p.in[5][(((size_t)b * NL + l) * 2 + dir) * DR + ch] : 0.f;
        const float* la = LA + (size_t)dir * NTOK * DR; const float* lb = LB + (size_t)dir * NTOK * DR;
#pragma unroll 1
        for (int tl = 0; tl < T / 128; ++tl) {
            float a[16], bb[16];
#pragma unroll
            for (int i = 0; i < 16; ++i) { const int pp = tl * 128 + seg * 16 + i; const int t = dir ? T - 1 - pp : pp; const size_t o = (size_t)(mseq + t) * DR + ch; a[i] = la[o]; bb[i] = lb[o]; }
            float A = 1.f, B = 0.f;
#pragma unroll
            for (int i = 0; i < 16; ++i) { B = a[i] * B + bb[i]; A *= a[i]; }
            AB[(buf * 8 + seg) * 64 + X.lane] = (f32x2){A, B};
            WG_SYNC();
            float h = carry, hin = carry;
#pragma unroll
            for (int s = 0; s < 8; ++s) { const f32x2 ab = AB[(buf * 8 + s) * 64 + X.lane]; if (s == seg) hin = h; h = ab.x * h + ab.y; }
            carry = h; buf ^= 1;
            float h2 = hin;
#pragma unroll
            for (int i = 0; i < 16; ++i) { const int pp = tl * 128 + seg * 16 + i; const int t = dir ? T - 1 - pp : pp; const size_t o = (size_t)(mseq + t) * DR + ch; h2 = a[i] * h2 + bb[i];
                if (dir == 0) HSF[o] = h2;
                else { const float hf = __hip_atomic_load(HSF + o, __ATOMIC_RELAXED, __HIP_MEMORY_SCOPE_AGENT); const float xg = bf2f(RNN[(size_t)(mseq + t) * 2048 + 1024 + ch]);
                    YL[o] = (bf16_t)(pk2((hf + h2) * gelu_tanh_f(xg), 0.f) & 0xffffu); } }
        }
        if (!lat && seg == 0) p.out[OUT_LRU + (((size_t)b * NL + l) * 2 + dir) * DR + ch] = carry;
        asm volatile("s_waitcnt vmcnt(0)" ::: "memory");
        WG_SYNC();
    }
}
__device__ __forceinline__ void lru_scan(const Ctx& X, const P& p, int l) {
    for (int it = X.c; it < 64 + 256; it += X.G) {
        if (it < 64) lru_scan_item(X, p, l, 1, it >> 4, it & 15); else lru_scan_item(X, p, l, 0, (it - 64) >> 4, (it - 64) & 15);
    }
}
__device__ __forceinline__ void mla_prep(const Ctx& X, const P& p, int l) {
    const float* MLAR = (const float*)(p.ws + WS_MLAR); bf16_t* CQN = (bf16_t*)(p.ws + WS_CQN); bf16_t* CKVA = (bf16_t*)(p.ws + WS_CKVA); bf16_t* KRA = (bf16_t*)(p.ws + WS_KRA);
    const float* TM = (const float*)(p.ws + WS_TABM); const float* gq = p.in[19] + (size_t)l * 512; const float* gkv = p.in[20] + (size_t)l * 256;
    const int gw = X.c * NWAVES + X.wave, NGW = X.G * NWAVES, ln = X.lane;
    for (int m = gw; m < NTOK + 1024; m += NGW) {
        if (m >= NTOK) {
            const int q = m - NTOK, b = q >> 8, s = q & 255; const size_t key = 4096 + (size_t)b * 1280 + s;
            const f32x4 cv = *(const f32x4*)(p.in[3] + (((size_t)b * NL + l) * 256 + s) * 256 + 4 * ln); u32x2 w; w.x = pk2(cv[0], cv[1]); w.y = pk2(cv[2], cv[3]); *(u32x2*)(CKVA + key * 256 + 4 * ln) = w;
            const float kv = p.in[4][(((size_t)b * NL + l) * 256 + s) * 64 + ln]; KRA[key * 64 + mla_new_of_old(ln)] = (bf16_t)(pk2(kv, 0.f) & 0xffffu);
            continue;
        }
        const float* r = MLAR + (size_t)m * 1024; const bool lat = m >= NCTX; const int t = lat ? (m - NCTX) & 1023 : m & 255; const int b = lat ? (m - NCTX) >> 10 : m >> 8;
        const size_t key = lat ? 4096 + (size_t)b * 1280 + 256 + t : (size_t)m;
        { const f32x4 q0 = *(const f32x4*)(r + 4 * ln), q1 = *(const f32x4*)(r + 256 + 4 * ln); float ss = (q0[0] * q0[0] + q0[1] * q0[1]) + (q0[2] * q0[2] + q0[3] * q0[3]) + (q1[0] * q1[0] + q1[1] * q1[1]) + (q1[2] * q1[2] + q1[3] * q1[3]);
          const float rs = 1.0f / sqrtf(wave_sum(ss) * (1.0f / 512) + 1e-6f); const f32x4 g0 = *(const f32x4*)(gq + 4 * ln), g1 = *(const f32x4*)(gq + 256 + 4 * ln); const f32x4 a = q0 * rs * g0, c = q1 * rs * g1;
          u32x2 w0, w1; w0.x = pk2(a[0], a[1]); w0.y = pk2(a[2], a[3]); w1.x = pk2(c[0], c[1]); w1.y = pk2(c[2], c[3]); *(u32x2*)(CQN + (size_t)m * 512 + 4 * ln) = w0; *(u32x2*)(CQN + (size_t)m * 512 + 256 + 4 * ln) = w1; }
        { const f32x4 cv = *(const f32x4*)(r + 512 + 4 * ln); const float ss = (cv[0] * cv[0] + cv[1] * cv[1]) + (cv[2] * cv[2] + cv[3] * cv[3]); const float rs = 1.0f / sqrtf(wave_sum(ss) * (1.0f / 256) + 1e-6f);
          const f32x4 o = cv * rs * *(const f32x4*)(gkv + 4 * ln); u32x2 w; w.x = pk2(o[0], o[1]); w.y = pk2(o[2], o[3]); *(u32x2*)(CKVA + key * 256 + 4 * ln) = w;
          if (!lat) *(f32x4*)(p.out + OUT_CKV + (((size_t)b * NL + l) * 256 + t) * 256 + 4 * ln) = o; }
        { const float kv = r[768 + ln]; float o = kv;
          if (lat) { const float pr = __shfl_xor(kv, 16); const int blk = ln >> 5, w = ln & 31, i = w & 15, part = w >> 4; const int pos = blk ? (t & 63) : (t >> 6); const float c = TM[(pos * 16 + i) * 2], s = TM[(pos * 16 + i) * 2 + 1];
              o = part ? (kv * c + pr * s) : (kv * c - pr * s); }
          else p.out[OUT_KROPE + (((size_t)b * NL + l) * 256 + t) * 64 + ln] = kv;
          KRA[key * 64 + mla_new_of_old(ln)] = (bf16_t)(pk2(o, 0.f) & 0xffffu); }
    }
}
}

namespace fx {
typedef short v4i16_t __attribute__((ext_vector_type(4)));
__device__ __forceinline__ s16x4 tr_read(const LAS bf16_t* p) { return __builtin_bit_cast(s16x4, __builtin_amdgcn_ds_read_tr16_b64_v4i16((LAS v4i16_t*)p)); }
__device__ __forceinline__ bf16x8 cat8(s16x4 a, s16x4 b) { return (bf16x8){a[0], a[1], a[2], a[3], b[0], b[1], b[2], b[3]}; }
constexpr int VSTR = 160;

struct AttnDesc {
    const bf16_t* Q; int qpitch;
    const bf16_t* K; int kpitch;
    const bf16_t* KR;
    const bf16_t* V; int vpitch;
    bf16_t* O;
    int nkeys;
    int tq0, T; float lgf, lgb;
    const float *S0f, *S0b;
    const bf16_t* RG;
};
template <int MODE> __device__ __forceinline__ void attn_unit(const Ctx& X, const AttnDesc& a) {
    constexpr int NK = MODE == 0 ? 12 : 8;
    constexpr int KSTR = MODE == 0 ? 200 : 136;
    constexpr int KCH = MODE == 0 ? 24 : 16;
    constexpr int KPT = MODE == 0 ? 3 : 2;
    LAS bf16_t* KT = (LAS bf16_t*)X.lds; LAS bf16_t* VT = KT + 64 * KSTR;
    const int r32 = X.lane & 31, hi = X.lane >> 5, wid = X.wave;
    bf16x8 qf[NK];
    { const bf16_t* qp = a.Q + (size_t)(32 * wid + r32) * a.qpitch + 8 * hi;
#pragma unroll
      for (int k = 0; k < NK; ++k) qf[k] = *(const bf16x8*)(qp + 16 * k); }
    f32x16 o[4];
#pragma unroll
    for (int d = 0; d < 4; ++d)
#pragma unroll
        for (int r = 0; r < 16; ++r) o[d][r] = 0.f;
    const int tr_row = (X.lane & 15) >> 2, tr_col = 16 * ((X.lane >> 4) & 1) + 4 * (X.lane & 3);
    const int tq = a.tq0 + 32 * wid + r32;
    if (MODE == 1 && a.S0f != nullptr) {
#pragma unroll 1
        for (int dir = 0; dir < 2; ++dir) {
            const float* S0 = dir ? a.S0b : a.S0f;
#pragma unroll
            for (int hh = 0; hh < 2; ++hh) {
                WG_SYNC();
                for (int e = X.tid; e < 64 * 32; e += NTHR) { const int row = e >> 5, c4 = (e & 31) * 4; const f32x4 v = *(const f32x4*)(S0 + (size_t)ret_old_of_new(64 * hh + row) * 128 + c4);
                    u32x2 w; w.x = pk2(v[0], v[1]); w.y = pk2(v[2], v[3]); *(LAS u32x2*)(VT + row * VSTR + c4) = w; }
                WG_SYNC();
#pragma unroll
                for (int kk = 0; kk < 4; ++kk)
#pragma unroll
                    for (int d = 0; d < 4; ++d) { const LAS bf16_t* vp = VT + (16 * kk + 8 * hi + tr_row) * VSTR + 32 * d + tr_col;
                        o[d] = __builtin_amdgcn_mfma_f32_32x32x16_bf16(cat8(tr_read(vp), tr_read(vp + 4 * VSTR)), qf[4 * hh + kk], o[d], 0, 0, 0); if (d == 3) __builtin_amdgcn_sched_barrier(0); }
            }
            const float aq = __builtin_amdgcn_exp2f(a.lgf * (float)(tq + 1)), bq = __builtin_amdgcn_exp2f(a.lgb * (float)(a.T - tq)); const float f = dir ? bq : aq / bq;
#pragma unroll
            for (int d = 0; d < 4; ++d)
#pragma unroll
                for (int r = 0; r < 16; ++r) o[d][r] *= f;
        }
    }
    u32x4 kreg[KPT], vreg[2];
#define GLOAD(t) do { \
        _Pragma("unroll") for (int i_ = 0; i_ < KPT; ++i_) { const int c_ = X.tid + NTHR * i_, row_ = c_ / KCH, chn_ = c_ % KCH; const size_t key_ = (size_t)(64 * (t) + row_); \
            if (MODE == 0 && chn_ >= 16) kreg[i_] = *(const u32x4*)(a.KR + key_ * 64 + 8 * (chn_ - 16)); else kreg[i_] = *(const u32x4*)(a.K + key_ * a.kpitch + 8 * chn_); } \
        _Pragma("unroll") for (int i_ = 0; i_ < 2; ++i_) { const int c_ = X.tid + NTHR * i_, row_ = c_ >> 4, chn_ = c_ & 15; vreg[i_] = *(const u32x4*)(a.V + (size_t)(64 * (t) + row_) * a.vpitch + 8 * chn_); } } while (0)
#define LSTORE() do { \
        _Pragma("unroll") for (int i_ = 0; i_ < KPT; ++i_) { const int c_ = X.tid + NTHR * i_, row_ = c_ / KCH, chn_ = c_ % KCH; *(LAS u32x4*)(KT + row_ * KSTR + 8 * chn_) = kreg[i_]; } \
        _Pragma("unroll") for (int i_ = 0; i_ < 2; ++i_) { const int c_ = X.tid + NTHR * i_, row_ = c_ >> 4, chn_ = c_ & 15; *(LAS u32x4*)(VT + row_ * VSTR + 8 * chn_) = vreg[i_]; } } while (0)
    const int NT = a.nkeys >> 6;
    float m_run = -INFINITY, l_run = 0.f;
    constexpr float CS = 0.07216878364870322f * 1.4426950408889634f;
    if (MODE == 1) GLOAD(0);
#pragma unroll 1
    for (int t = 0; t < NT; ++t) {
        WG_SYNC();
        if (MODE == 0) GLOAD(t);
        LSTORE();
        WG_SYNC();
        f32x16 s0, s1;
#pragma unroll
        for (int r = 0; r < 16; ++r) { s0[r] = 0.f; s1[r] = 0.f; }
#pragma unroll
        for (int k = 0; k < NK; ++k) { const bf16x8 k0 = *(const LAS bf16x8*)(KT + r32 * KSTR + 16 * k + 8 * hi), k1 = *(const LAS bf16x8*)(KT + (32 + r32) * KSTR + 16 * k + 8 * hi);
            s0 = __builtin_amdgcn_mfma_f32_32x32x16_bf16(k0, qf[k], s0, 0, 0, 0); s1 = __builtin_amdgcn_mfma_f32_32x32x16_bf16(k1, qf[k], s1, 0, 0, 0); if (k & 1) __builtin_amdgcn_sched_barrier(0); }
        if (MODE == 0) {
            float mx = fmaxf(s0[0], s1[0]);
#pragma unroll
            for (int r = 1; r < 16; ++r) mx = fmaxf(mx, fmaxf(s0[r], s1[r]));
            mx = fmaxf(mx, __shfl_xor(mx, 32));
            const float mn = fmaxf(m_run, mx); const float alpha = __builtin_amdgcn_exp2f((m_run - mn) * CS); m_run = mn; float ls = 0.f;
#pragma unroll
            for (int r = 0; r < 16; ++r) { s0[r] = __builtin_amdgcn_exp2f((s0[r] - mn) * CS); s1[r] = __builtin_amdgcn_exp2f((s1[r] - mn) * CS); ls += s0[r] + s1[r]; }
            l_run = l_run * alpha + ls;
#pragma unroll
            for (int d = 0; d < 4; ++d)
#pragma unroll
                for (int r = 0; r < 16; ++r) o[d][r] *= alpha;
        } else {
            const int kb = 64 * t + 4 * hi;
#pragma unroll
            for (int r = 0; r < 16; ++r) { const int k0p = kb + (r & 3) + 8 * (r >> 2); const int d0 = tq - k0p, d1 = d0 - 32;
                const float e0 = d0 > 0 ? __builtin_amdgcn_exp2f(a.lgf * (float)d0) : (d0 < 0 ? __builtin_amdgcn_exp2f(a.lgb * (float)(-d0)) : 2.0f);
                const float e1 = d1 > 0 ? __builtin_amdgcn_exp2f(a.lgf * (float)d1) : (d1 < 0 ? __builtin_amdgcn_exp2f(a.lgb * (float)(-d1)) : 2.0f);
                s0[r] *= e0 * 0.08838834764831845f; s1[r] *= e1 * 0.08838834764831845f; }
        }
        if (MODE == 1 && t + 1 < NT) GLOAD(t + 1);
        bf16x8 pf[2][2];
#pragma unroll
        for (int st = 0; st < 2; ++st) { u32x4 w0, w1; w0.x = pk2(s0[8 * st + 0], s0[8 * st + 1]); w0.y = pk2(s0[8 * st + 2], s0[8 * st + 3]); w0.z = pk2(s0[8 * st + 4], s0[8 * st + 5]); w0.w = pk2(s0[8 * st + 6], s0[8 * st + 7]);
            w1.x = pk2(s1[8 * st + 0], s1[8 * st + 1]); w1.y = pk2(s1[8 * st + 2], s1[8 * st + 3]); w1.z = pk2(s1[8 * st + 4], s1[8 * st + 5]); w1.w = pk2(s1[8 * st + 6], s1[8 * st + 7]);
            pf[0][st] = __builtin_bit_cast(bf16x8, w0); pf[1][st] = __builtin_bit_cast(bf16x8, w1); }
#pragma unroll
        for (int b = 0; b < 2; ++b)
#pragma unroll
            for (int st = 0; st < 2; ++st)
#pragma unroll
                for (int d = 0; d < 4; ++d) { const LAS bf16_t* vp = VT + (32 * b + 16 * st + 4 * hi + tr_row) * VSTR + 32 * d + tr_col;
                    o[d] = __builtin_amdgcn_mfma_f32_32x32x16_bf16(cat8(tr_read(vp), tr_read(vp + 8 * VSTR)), pf[b][st], o[d], 0, 0, 0); if (d == 3) __builtin_amdgcn_sched_barrier(0); }
    }
    bf16_t* op = a.O + (size_t)(32 * wid + r32) * 1024;
    if (MODE == 0) {
        const float lt = l_run + __shfl_xor(l_run, 32); const float il = 1.0f / lt;
#pragma unroll
        for (int d = 0; d < 4; ++d)
#pragma unroll
            for (int g = 0; g < 4; ++g) { u32x2 w; w.x = pk2(o[d][4 * g] * il, o[d][4 * g + 1] * il); w.y = pk2(o[d][4 * g + 2] * il, o[d][4 * g + 3] * il); *(u32x2*)(op + 32 * d + 8 * g + 4 * hi) = w; }
    } else {
        float s = 0.f;
#pragma unroll
        for (int d = 0; d < 4; ++d)
#pragma unroll
            for (int r = 0; r < 16; ++r) s += o[d][r];
        s += __shfl_xor(s, 32); const float mu = s * (1.0f / 128); float v = 0.f;
#pragma unroll
        for (int d = 0; d < 4; ++d)
#pragma unroll
            for (int r = 0; r < 16; ++r) { const float e = o[d][r] - mu; v += e * e; }
        v += __shfl_xor(v, 32); const float rs = 1.0f / sqrtf(v * (1.0f / 128) + 1e-6f);
        const bf16_t* gp = a.RG + (size_t)(32 * wid + r32) * 4096;
#pragma unroll
        for (int d = 0; d < 4; ++d)
#pragma unroll
            for (int g = 0; g < 4; ++g) { const int dv = 32 * d + 8 * g + 4 * hi; const u32x2 gw = *(const u32x2*)(gp + dv); const float g0 = lo_bf(gw.x), g1 = hi_bf(gw.x), g2 = lo_bf(gw.y), g3 = hi_bf(gw.y);
                u32x2 w; w.x = pk2((o[d][4 * g] - mu) * rs * (g0 * fsigm(g0)), (o[d][4 * g + 1] - mu) * rs * (g1 * fsigm(g1))); w.y = pk2((o[d][4 * g + 2] - mu) * rs * (g2 * fsigm(g2)), (o[d][4 * g + 3] - mu) * rs * (g3 * fsigm(g3)));
                *(u32x2*)(op + dv) = w; }
    }
    WG_SYNC();
#undef GLOAD
#undef LSTORE
}
__device__ __forceinline__ void ret_state_unit(const Ctx& X, const P& p, int l, int b, int h) {
    LAS bf16_t* KF = (LAS bf16_t*)X.lds; LAS bf16_t* KB = KF + 64 * VSTR; LAS bf16_t* VT = KB + 64 * VSTR;
    const bf16_t* RET = (const bf16_t*)(p.ws + WS_RET) + (size_t)(b * 256) * 4096 + h * 128;
    const float dlf = p.in[23][((size_t)l * 2 + 0) * 8 + h], dlb = p.in[23][((size_t)l * 2 + 1) * 8 + h];
    const float lgf = -(fmaxf(-dlf, 0.f) + log1pf(__expf(-fabsf(dlf)))) * 1.4426950408889634f, lgb = -(fmaxf(-dlb, 0.f) + log1pf(__expf(-fabsf(dlb)))) * 1.4426950408889634f;
    const int r32 = X.lane & 31, hi = X.lane >> 5, dir = X.wave >> 2, dkb = X.wave & 3;
    const int tr_row = (X.lane & 15) >> 2, tr_col = 16 * ((X.lane >> 4) & 1) + 4 * (X.lane & 3);
    f32x16 acc[4];
#pragma unroll
    for (int d = 0; d < 4; ++d)
#pragma unroll
        for (int r = 0; r < 16; ++r) acc[d][r] = 0.f;
#pragma unroll 1
    for (int t = 0; t < 4; ++t) {
        WG_SYNC();
#pragma unroll
        for (int i = 0; i < 2; ++i) { const int c = X.tid + NTHR * i, row = c >> 4, chn = c & 15; const int s = 64 * t + row;
            const u32x4 kv = *(const u32x4*)(RET + (size_t)s * 4096 + 1024 + 8 * chn); const u32x4 vv = *(const u32x4*)(RET + (size_t)s * 4096 + 2048 + 8 * chn);
            const float wf = __builtin_amdgcn_exp2f(lgf * (float)(255 - s)) * 0.08838834764831845f, wb = __builtin_amdgcn_exp2f(lgb * (float)s) * 0.08838834764831845f;
            u32x4 of, ob; const unsigned kw[4] = {kv.x, kv.y, kv.z, kv.w}; unsigned fw[4], bw[4];
#pragma unroll
            for (int e = 0; e < 4; ++e) { const float x0 = lo_bf(kw[e]), x1 = hi_bf(kw[e]); fw[e] = pk2(x0 * wf, x1 * wf); bw[e] = pk2(x0 * wb, x1 * wb); }
            of = (u32x4){fw[0], fw[1], fw[2], fw[3]}; ob = (u32x4){bw[0], bw[1], bw[2], bw[3]};
            *(LAS u32x4*)(KF + row * VSTR + 8 * chn) = of; *(LAS u32x4*)(KB + row * VSTR + 8 * chn) = ob; *(LAS u32x4*)(VT + row * VSTR + 8 * chn) = vv; }
        WG_SYNC();
        const LAS bf16_t* KW = dir ? KB : KF;
#pragma unroll
        for (int kk = 0; kk < 4; ++kk) { const LAS bf16_t* kp = KW + (16 * kk + 8 * hi + tr_row) * VSTR + 32 * dkb + tr_col; const bf16x8 af = cat8(tr_read(kp), tr_read(kp + 4 * VSTR));
#pragma unroll
            for (int d = 0; d < 4; ++d) { const LAS bf16_t* vp = VT + (16 * kk + 8 * hi + tr_row) * VSTR + 32 * d + tr_col;
                acc[d] = __builtin_amdgcn_mfma_f32_32x32x16_bf16(af, cat8(tr_read(vp), tr_read(vp + 4 * VSTR)), acc[d], 0, 0, 0); } __builtin_amdgcn_sched_barrier(0); }
    }
    float* outp = p.out + OUT_RET + ((((size_t)b * NL + l) * 2 + dir) * 8 + h) * 128 * 128;
#pragma unroll
    for (int d = 0; d < 4; ++d)
#pragma unroll
        for (int r = 0; r < 16; ++r) outp[(size_t)ret_old_of_new(32 * dkb + crow(r, hi)) * 128 + 32 * d + r32] = acc[d][r];
    WG_SYNC();
}
__device__ __forceinline__ float log2_sigmoid(float x) { return -(fmaxf(-x, 0.f) + log1pf(__expf(-fabsf(x)))) * 1.4426950408889634f; }
__device__ __forceinline__ void ret_unit(const Ctx& X, const P& p, int l, int u) {
    const bf16_t* RET = (const bf16_t*)(p.ws + WS_RET); bf16_t* ORET = (bf16_t*)(p.ws + WS_YCAT) + (size_t)2 * NTOK * 1024; AttnDesc a;
    int b, h, mq, mk;
    if (u < 128) { b = u >> 5; h = (u >> 2) & 7; const int qt = u & 3; mk = NCTX + b * 1024; mq = mk + qt * 256; a.tq0 = qt * 256; a.T = 1024; a.nkeys = 1024;
        a.S0f = p.in[6] + ((((size_t)b * NL + l) * 2 + 0) * 8 + h) * 16384; a.S0b = p.in[6] + ((((size_t)b * NL + l) * 2 + 1) * 8 + h) * 16384; }
    else { const int v = u - 128; b = v >> 3; h = v & 7; mk = b * 256; mq = mk; a.tq0 = 0; a.T = 256; a.nkeys = 256; a.S0f = nullptr; a.S0b = nullptr; }
    a.Q = RET + (size_t)mq * 4096 + h * 128; a.qpitch = 4096; a.K = RET + (size_t)mk * 4096 + 1024 + h * 128; a.kpitch = 4096; a.KR = nullptr; a.V = RET + (size_t)mk * 4096 + 2048 + h * 128; a.vpitch = 4096;
    a.RG = RET + (size_t)mq * 4096 + 3072 + h * 128; a.O = ORET + (size_t)mq * 1024 + h * 128;
    a.lgf = log2_sigmoid(p.in[23][((size_t)l * 2 + 0) * 8 + h]); a.lgb = log2_sigmoid(p.in[23][((size_t)l * 2 + 1) * 8 + h]);
    attn_unit<1>(X, a);
}
__device__ __forceinline__ void mla_unit(const Ctx& X, const P& p, int u) {
    AttnDesc a; int b, h, mq, k0;
    if (u < 128) { b = u >> 5; h = (u >> 2) & 7; const int qt = u & 3; mq = NCTX + b * 1024 + qt * 256; k0 = 4096 + b * 1280; a.nkeys = 1280; }
    else { const int v = u - 128; b = v >> 3; h = v & 7; mq = b * 256; k0 = b * 256; a.nkeys = 256; }
    a.Q = (const bf16_t*)(p.ws + WS_QMLA) + (size_t)mq * 1536 + h * 192; a.qpitch = 1536; a.K = (const bf16_t*)(p.ws + WS_KN) + (size_t)k0 * 1024 + h * 128; a.kpitch = 1024; a.KR = (const bf16_t*)(p.ws + WS_KRA) + (size_t)k0 * 64;
    a.V = (const bf16_t*)(p.ws + WS_VM) + (size_t)k0 * 1024 + h * 128; a.vpitch = 1024; a.O = (bf16_t*)(p.ws + WS_YCAT) + (size_t)NTOK * 1024 + (size_t)mq * 1024 + h * 128;
    a.tq0 = 0; a.T = 0; a.lgf = 0.f; a.lgb = 0.f; a.S0f = nullptr; a.S0b = nullptr; a.RG = nullptr;
    attn_unit<0>(X, a);
}
}

#define XB_TMO      128
#define XB_XCNT(j)  (256  + 64 * (j))
#define XB_XSUB(j)  (1280 + 64 * (j))
#define XB_XGEN(j)  (2304 + 64 * (j))
#define XB_TOP      3328
#define XB_TOPGEN   3392
#define XCD_BAR_WORDS 3456
#define XB_SPIN_CAP (1u << 18)

__device__ __forceinline__ unsigned xb_ld(unsigned* p)              { return __hip_atomic_load(p, __ATOMIC_RELAXED, __HIP_MEMORY_SCOPE_AGENT); }
__device__ __forceinline__ unsigned xb_add(unsigned* p, unsigned v) { return __hip_atomic_fetch_add(p, v, __ATOMIC_RELAXED, __HIP_MEMORY_SCOPE_AGENT); }
__device__ __forceinline__ unsigned xb_xcc_id() { return (unsigned)__builtin_amdgcn_s_getreg((3 << 11) | 20) & 0xFu; }
#define XB_SPIN(cond, bar) do { unsigned _sp = 0; while (cond) { __builtin_amdgcn_s_sleep(1); \
    if ((++_sp & 255u) == 0u) { if (xb_ld(&(bar)[XB_TMO])) break; if (_sp > XB_SPIN_CAP) { atomicAdd(&(bar)[XB_TMO], 1u); break; } } } } while (0)

struct XcdBarrier {
    unsigned* bar; unsigned x;
    volatile LAS unsigned* st;
};
__device__ __forceinline__ XcdBarrier xcd_barrier_post(unsigned* bar, volatile LAS unsigned* st) {
    XcdBarrier b; b.bar = bar; b.x = xb_xcc_id(); b.st = st;
    if (threadIdx.x == 0) (void)xb_add(&bar[XB_XCNT(b.x)], 1u);
    return b;
}
__device__ __forceinline__ void xcd_barrier_complete(unsigned* bar, unsigned x, unsigned& nloc, unsigned& nx) {
    const unsigned G = gridDim.x * gridDim.y * gridDim.z;
    unsigned sum, cnt, mine, sp = 0u;
    for (;;) {
        sum = 0u; cnt = 0u; mine = 0u;
#pragma unroll
        for (unsigned j = 0; j < 16; ++j) { const unsigned c = xb_ld(&bar[XB_XCNT(j)]); sum += c; cnt += (c > 0u) ? 1u : 0u; mine = (j == x) ? c : mine; }
        if (sum == G) break;
        __builtin_amdgcn_s_sleep(1);
        if ((++sp & 255u) == 0u) { if (xb_ld(&bar[XB_TMO])) break; if (sp > XB_SPIN_CAP) { atomicAdd(&bar[XB_TMO], 1u); break; } }
    }
    nloc = mine > 0u ? mine : 1u; nx = cnt > 0u ? cnt : 1u;
}
__device__ __forceinline__ void xcd_barrier(const XcdBarrier& b) {
    asm volatile("s_waitcnt vmcnt(0)" ::: "memory");
    __syncthreads();
    if (threadIdx.x == 0) {
        unsigned* bar = b.bar;
        __builtin_amdgcn_s_waitcnt(0);
        unsigned nloc = b.st[0], nx = b.st[1];
        if (nloc == 0u) { xcd_barrier_complete(bar, b.x, nloc, nx); b.st[0] = nloc; b.st[1] = nx; }
        const unsigned old = xb_add(&bar[XB_XSUB(b.x)], 1u);
        const unsigned gen = old / nloc;
        if (old + 1u == (gen + 1u) * nloc) {
            __builtin_amdgcn_fence(__ATOMIC_RELEASE, "agent");
            asm volatile("s_waitcnt vmcnt(0)" ::: "memory");
            const unsigned og = xb_add(&bar[XB_TOP], 1u);
            const unsigned tg = og / nx;
            if (og + 1u == (tg + 1u) * nx) xb_add(&bar[XB_TOPGEN], 1u);
            else XB_SPIN(xb_ld(&bar[XB_TOPGEN]) == tg, bar);
            __builtin_amdgcn_fence(__ATOMIC_ACQUIRE, "agent");
            xb_add(&bar[XB_XGEN(b.x)], 1u);
            asm volatile("s_waitcnt vmcnt(0)" ::: "memory");
        } else {
            XB_SPIN(xb_ld(&bar[XB_XGEN(b.x)]) == gen, bar);
            __builtin_amdgcn_fence(__ATOMIC_ACQUIRE, "agent");
            asm volatile("s_waitcnt vmcnt(0)" ::: "memory");
        }
    }
    __syncthreads();
}

namespace fx {
constexpr int NPHASE = 2 + 11 * NL;
#ifndef FX_PHMASK
#define FX_PHMASK 0xFFFF
#endif
#define PHON(j) ((FX_PHMASK >> (j)) & 1)
#ifndef FX_SUB
#define FX_SUB 0xF
#endif
#define SUBON(j) ((FX_SUB >> (j)) & 1)
__global__ void __launch_bounds__(NTHR, 2) mega(P p) {
    extern __shared__ __attribute__((aligned(16))) unsigned char lds_raw[];
    Ctx X; X.lds = (LAS unsigned char*)lds_raw; X.tid = threadIdx.x; X.lane = X.tid & 63; X.wave = __builtin_amdgcn_readfirstlane(X.tid >> 6); X.G = gridDim.x; X.c = blockIdx.x;
    volatile LAS unsigned* MISC = (volatile LAS unsigned*)(X.lds + LDS_MISC);
    if (X.tid < 16) MISC[X.tid] = 0u;
    __syncthreads();
    unsigned* ctl = (unsigned*)(p.ws + WS_CTL);
    const bool multi = (p.ph_hi - p.ph_lo) > 1;
    XcdBarrier bar; bar.bar = ctl + CW_BAR; bar.x = 0; bar.st = MISC + 8;
    if (multi) bar = xcd_barrier_post(ctl + CW_BAR, MISC + 8);
    const int lo = p.ph_lo, hi = p.ph_hi;
#define IN(k) (lo <= (k) && (k) < hi)
#define SEAM(k) do { if (IN(k) && IN((k) + 1)) xcd_barrier(bar); } while (0)
    LAS unsigned char* ring = X.lds;
#define FRESH(Y) Ctx Y = X; { int t_ = X.tid; asm volatile("" : "+v"(t_)); Y.tid = t_; Y.lane = t_ & 63; Y.wave = __builtin_amdgcn_readfirstlane(t_ >> 6); }
    if (PHON(11) && IN(0)) { FRESH(Y) convert_weights(Y, p); __syncthreads(); ada_partials(Y, p); make_tables(Y, p); }
    SEAM(0);
    if (PHON(11) && IN(1)) { FRESH(Y) ada_reduce(Y, p); }
    SEAM(1);
#pragma unroll 1
    for (int l = p.l_lo; l < p.l_hi; ++l) {
        const int pb = 2 + 11 * l; unsigned char* wl = p.ws + WS_W + (size_t)l * WL_STRIDE;
        if (PHON(0) && IN(pb + 0) && l == p.l_lo) { FRESH(Y) rowwise<0>(Y, p, l); }
        if (l == p.l_lo) SEAM(pb + 0);
        if (PHON(1) && IN(pb + 1)) {
            pg8::Gemm g{(const bf16_t*)(p.ws + WS_H), (const bf16_t*)(wl + WO_WIN), NTOK, NINP, D}; pg8::StaticOrder S; S.init(NTOK, NINP, X.G, X.c);
            pg8::EpiWin E{(bf16_t*)(p.ws + WS_RNN), (bf16_t*)(p.ws + WS_RET), (bf16_t*)(p.ws + WS_GATES), (float*)(p.ws + WS_MLAR), (const float*)(p.ws + WS_TABR)};
            pg8::gemm_phase<pg8::EpiWin, pg8::StaticOrder, true, true>(ring, g, S, E);
        }
        SEAM(pb + 1);
        if (PHON(2) && IN(pb + 2)) {
            if (SUBON(0)) { FRESH(Y) for (int u = X.c; u < 256; u += X.G) ret_unit(Y, p, l, u); }
            if (SUBON(1)) if (X.c >= 128 || X.G < 256) { FRESH(Y) for (int u = (X.G < 256 ? X.c : X.c - 128); u < 128; u += (X.G < 256 ? X.G : 128)) ret_state_unit(Y, p, l, u >> 3, u & 7); }
            if (SUBON(2)) { FRESH(Y) lru_gates(Y, p, l); }
            if (SUBON(3)) { FRESH(Y) mla_prep(Y, p, l); }
        }
        SEAM(pb + 2);
        if (PHON(3) && IN(pb + 3)) {
            if (SUBON(0)) { pg8::Gemm g{(const bf16_t*)(p.ws + WS_CQN), (const bf16_t*)(wl + WO_WUQ), NTOK, 1536, 512}; pg8::StaticOrder S; S.init(NTOK, 1536, X.G, X.c);
              pg8::EpiQup E{(bf16_t*)(p.ws + WS_QMLA), (const float*)(p.ws + WS_TABM)};
              pg8::gemm_phase<pg8::EpiQup, pg8::StaticOrder, true, true>(ring, g, S, E); }
            if (SUBON(1)) { pg8::Gemm g{(const bf16_t*)(p.ws + WS_CKVA), (const bf16_t*)(wl + WO_WUKV), NKEY, 2048, 256}; pg8::StaticOrder S; S.init(NKEY, 2048, X.G, (X.c + 192) % X.G);
              pg8::EpiSplit E{(bf16_t*)(p.ws + WS_KN), (bf16_t*)(p.ws + WS_VM), 1024, 4};
              pg8::gemm_phase<pg8::EpiSplit, pg8::StaticOrder, true, true>(ring, g, S, E); }
            __syncthreads();
            if (SUBON(2)) { FRESH(Y) lru_scan(Y, p, l); }
        }
        SEAM(pb + 3);
        if (PHON(4) && IN(pb + 4)) { FRESH(Y) for (int u = X.c; u < 256; u += X.G) mla_unit(Y, p, u); }
        SEAM(pb + 4);
        if (PHON(5) && IN(pb + 5)) {
            pg8::Gemm g{(const bf16_t*)(p.ws + WS_YCAT), (const bf16_t*)(wl + WO_WBR), 3 * NTOK, 3 * 2048, 1024}; pg8::BranchOrder S; S.init(X.G, X.c);
            pg8::EpiBranch E{(const bf16_t*)(p.ws + WS_GATES), (float*)(p.ws + WS_TMP), (bf16_t*)(p.ws + WS_MERGED)};
            pg8::gemm_phase<pg8::EpiBranch, pg8::BranchOrder, true, true>(ring, g, S, E);
        }
        SEAM(pb + 5);
        if (PHON(6) && IN(pb + 6)) {
            pg8::Gemm g{(const bf16_t*)(p.ws + WS_MERGED), (const bf16_t*)(wl + WO_WOUT), NTOK, D, D}; pg8::StaticOrder S; S.init(NTOK, D, X.G, X.c);
            pg8::EpiF32 E{(float*)(p.ws + WS_U), D};
            pg8::gemm_phase<pg8::EpiF32, pg8::StaticOrder, true, true>(ring, g, S, E);
        }
        SEAM(pb + 6);
        if (PHON(7) && IN(pb + 7)) { FRESH(Y) rowwise<1>(Y, p, l); }
        SEAM(pb + 7);
        if (PHON(8) && IN(pb + 8)) {
            pg8::Gemm g{(const bf16_t*)(p.ws + WS_H), (const bf16_t*)(wl + WO_W1), NTOK, FF, D}; pg8::StaticOrder S; S.init(NTOK, FF, X.G, X.c);
            pg8::EpiRelu2 E{(bf16_t*)(p.ws + WS_HID), FF};
            pg8::gemm_phase<pg8::EpiRelu2, pg8::StaticOrder, true, true>(ring, g, S, E);
        }
        SEAM(pb + 8);
        if (PHON(9) && IN(pb + 9)) {
            pg8::Gemm g{(const bf16_t*)(p.ws + WS_HID), (const bf16_t*)(wl + WO_W2), NTOK, D, FF}; pg8::StaticOrder S; S.init(NTOK, D, X.G, X.c);
            pg8::EpiF32 E{(float*)(p.ws + WS_U), D};
            pg8::gemm_phase<pg8::EpiF32, pg8::StaticOrder, true, true>(ring, g, S, E);
        }
        SEAM(pb + 9);
        if (PHON(10) && IN(pb + 10)) { FRESH(Y) rowwise<2>(Y, p, l); }
        SEAM(pb + 10);
    }
#undef IN
#undef SEAM
}
static void launch_mega(const P& p0, int lo, int hi, int l_lo, int l_hi, hipStream_t st) {
    static int grid = 0;
    if (grid == 0) { int dev = 0, cus = 0; hipGetDevice(&dev); hipDeviceGetAttribute(&cus, hipDeviceAttributeMultiprocessorCount, dev);
        hipFuncSetAttribute((const void*)mega, hipFuncAttributeMaxDynamicSharedMemorySize, LDS_BYTES);
        int per_cu = 0; if (hipOccupancyMaxActiveBlocksPerMultiprocessor(&per_cu, (const void*)mega, NTHR, LDS_BYTES) != hipSuccess || per_cu < 1) fprintf(stderr, "occupancy query: %d\n", per_cu);
        (void)hipGetLastError(); grid = cus > 0 ? cus : 256; }
    P p = p0; p.ph_lo = lo; p.ph_hi = hi; p.l_lo = l_lo; p.l_hi = l_hi;
    hipLaunchKernelGGL(mega, dim3(grid), dim3(NTHR), LDS_BYTES, st, p);
}
}

#if FX_DBG
#ifndef FX_TL
#define FX_TL 0
#endif
namespace dbg {
struct Hook : nv::HookBase {
    hipStream_t st; nv::Dims d; nv::Out o; nv::Bufs b; fx::P p; unsigned char* ws; float* stat; float* xf; float* fake; unsigned char *h0s, *usnap, *xmid, *hmid; int TL;
    void cmp(int id, const void* fp, int fbf16, long fld, int m0, int fcol, const float* rp, long rld, int rcol, int R, int C, int perm = 0, int rtf = 0, float rscale = 1.0f) {
        MatCmp f{fp, rp, fld, rld, R, C, m0, fcol, rcol, fbf16, perm, rtf, rscale, 0}; static_assert(__has_unique_object_representations(MatCmp) || true, "");
        const long n = (long)R * C; hipLaunchKernelGGL(k_cmp, dim3(1024), dim3(256), 0, st, f, n, stat, id);
    }
    void layer_begin(int l) override {
        if (l != TL) return;
        using namespace fx;
        hipMemcpyAsync(xf, o.y_prompt, (size_t)NTOK * D * 4, hipMemcpyDeviceToDevice, st);
        const int pb = 2 + 11 * l;
        launch_mega(p, 0, 1, l, l + 1, st); launch_mega(p, 1, 2, l, l + 1, st);
        launch_mega(p, pb + 0, pb + 1, l, l + 1, st); hipMemcpyAsync(h0s, ws + WS_H, SZ_H, hipMemcpyDeviceToDevice, st);
        for (int j = 1; j <= 6; ++j) launch_mega(p, pb + j, pb + j + 1, l, l + 1, st);
        hipMemcpyAsync(usnap, ws + WS_U, SZ_U, hipMemcpyDeviceToDevice, st);
        launch_mega(p, pb + 7, pb + 8, l, l + 1, st);
        hipMemcpyAsync(xmid, xf, (size_t)NTOK * D * 4, hipMemcpyDeviceToDevice, st); hipMemcpyAsync(hmid, ws + WS_H, SZ_H, hipMemcpyDeviceToDevice, st);
        for (int j = 8; j <= 10; ++j) launch_mega(p, pb + j, pb + j + 1, l, l + 1, st);
    }
    void hook(int s, int l, const nv::Chunk& k) override {
        if (l != TL) return;
        using namespace fx;
        const int m0 = k.grp ? NCTX + k.b0 * 1024 : k.b0 * 256, R = k.R; const int key0 = k.grp ? 4096 + k.b0 * 1280 : k.b0 * 256, KR_ = k.nb * k.Sk;
        const float* xnaive = (k.grp ? o.y_sample : o.y_prompt) + (size_t)k.b0 * k.T * D;
        switch (s) {
        case 0: cmp(0, h0s, 1, D, m0, 0, b.h, D, 0, R, D); break;
        case 1: cmp(1, ws + WS_RNN, 1, 2048, m0, 0, b.proj, d.NIN, 0, R, 2048); cmp(4, ws + WS_RET, 1, 4096, m0, 2048, b.proj, d.NIN, d.o_rv, R, 1024); cmp(5, ws + WS_RET, 1, 4096, m0, 3072, b.proj, d.NIN, d.o_rg, R, 1024);
                cmp(6, ws + WS_GATES, 1, 6144, m0, 0, b.proj, d.NIN, d.o_gates, R, 6144, 0, 1); cmp(7, ws + WS_MLAR, 0, 1024, m0, 0, b.proj, d.NIN, d.o_cq, R, 832); break;
        case 2: for (int dir = 0; dir < 2; ++dir) { cmp(8 + dir, (float*)(ws + WS_LA) + (size_t)dir * NTOK * DR, 0, DR, m0, 0, b.la + (size_t)dir * R * DR, DR, 0, R, DR); cmp(10 + dir, (float*)(ws + WS_LB) + (size_t)dir * NTOK * DR, 0, DR, m0, 0, b.lb + (size_t)dir * R * DR, DR, 0, R, DR); } break;
        case 3: if (!k.grp) cmp(13, fake + (OUT_LRU - OUT_CKV) + (size_t)l * 2 * DR, 0, (long)NL * 2 * DR, k.b0, 0, o.new_lru + ((size_t)k.b0 * NL + l) * 2 * DR, (long)NL * 2 * DR, 0, k.nb, 2 * DR); break;
        case 4: cmp(12, ws + WS_YCAT, 1, 1024, m0, 0, b.ylru, DR, 0, R, DR); break;
        case 5: cmp(14, ws + WS_CQN, 1, 512, m0, 0, b.cqn, 512, 0, R, 512); break;
        case 6: cmp(15, ws + WS_CKVA, 1, 256, key0, 0, b.ckvall, 256, 0, KR_, 256); cmp(16, ws + WS_KRA, 1, 64, key0, 0, b.kropeall, 64, 0, KR_, 64, 3);
                if (!k.grp) { cmp(17, fake + (size_t)l * 65536, 0, (long)NL * 65536, k.b0, 0, o.new_ckv + ((size_t)k.b0 * NL + l) * 65536, (long)NL * 65536, 0, k.nb, 65536);
                              cmp(18, fake + (OUT_KROPE - OUT_CKV) + (size_t)l * 16384, 0, (long)NL * 16384, k.b0, 0, o.new_krope + ((size_t)k.b0 * NL + l) * 16384, (long)NL * 16384, 0, k.nb, 16384); } break;
        case 7: cmp(19, ws + WS_QMLA, 1, 1536, m0, 0, b.q, 1536, 0, R, 1536, 2); break;
        case 8: cmp(20, ws + WS_KN, 1, 1024, key0, 0, b.kv, 2048, 0, KR_, 1024, 4); cmp(21, ws + WS_VM, 1, 1024, key0, 0, b.kv, 2048, 0, KR_, 1024, 5); break;
        case 9: cmp(22, ws + WS_YCAT + (size_t)NTOK * 1024 * 2, 1, 1024, m0, 0, b.omla, 1024, 0, R, 1024); break;
        case 10: cmp(2, ws + WS_RET, 1, 4096, m0, 0, b.rq2, 1024, 0, R, 1024, 1); cmp(3, ws + WS_RET, 1, 4096, m0, 1024, b.rk2, 1024, 0, R, 1024, 1, 0, 11.313708498984761f); break;
        case 11: cmp(23, ws + WS_YCAT + (size_t)2 * NTOK * 1024 * 2, 1, 1024, m0, 0, b.onorm, 1024, 0, R, 1024); break;
        case 12: cmp(24, fake + (OUT_RET - OUT_CKV) + (size_t)l * 2 * 8 * 16384, 0, (long)NL * 2 * 8 * 16384, k.b0, 0, o.new_ret + ((size_t)k.b0 * NL + l) * 2 * 8 * 16384, (long)NL * 2 * 8 * 16384, 0, k.nb, 2 * 8 * 16384); break;
        case 13: cmp(25, ws + WS_MERGED, 1, D, m0, 0, b.merged, D, 0, R, D); break;
        case 14: cmp(26, usnap, 0, D, m0, 0, b.u, D, 0, R, D); break;
        case 15: cmp(27, xmid, 0, D, m0, 0, xnaive, D, 0, R, D); break;
        case 16: cmp(28, hmid, 1, D, m0, 0, b.h, D, 0, R, D); break;
        case 17: cmp(29, ws + WS_HID, 1, FF, m0, 0, b.hid, FF, 0, R, FF); break;
        case 18: cmp(30, ws + WS_U, 0, D, m0, 0, b.u, D, 0, R, D); break;
        case 19: cmp(31, xf, 0, D, m0, 0, xnaive, D, 0, R, D); break;
        default: break;
        }
    }
};
}
#endif

extern "C" void kernel_launch(void* const* d_in, const int* in_sizes, int n_in, void* d_out, int out_size, void* d_ws, size_t ws_size, hipStream_t stream) {
    using namespace fx;
    unsigned char* ws = (unsigned char*)d_ws;
    P p{}; for (int i = 0; i < 30; ++i) p.in[i] = (const float*)d_in[i]; p.ws = ws;
#if !FX_DBG
    if (ws_size < WS_FAST_END || n_in != 30) { fprintf(stderr, "kernel_launch: need %zu bytes of workspace, have %zu\n", (size_t)WS_FAST_END, ws_size); return; }
    hipMemsetAsync(ws + WS_CTL, 0, CTL_BYTES, stream);
    p.out = (float*)d_out; p.xres = (float*)d_out;
    launch_mega(p, 0, NPHASE, 0, NL, stream);
#else
    const nv::Dims d = nv::full_dims();
    nv::In in; { const float* q[30]; for (int i = 0; i < 30; ++i) q[i] = (const float*)d_in[i]; memcpy(&in, q, sizeof(in)); }
    const nv::Out o = nv::make_out(d, (float*)d_out);
    size_t off = (WS_FAST_END + 255) & ~(size_t)255;
    auto carve = [&](size_t bytes) { unsigned char* q = ws + off; off += (bytes + 255) & ~(size_t)255; return q; };
    float* stat = (float*)carve(4096); float* xf = (float*)carve((size_t)NTOK * D * 4); float* fake = (float*)carve((size_t)(OUT_END - OUT_CKV) * 4);
    unsigned char* h0s = carve(SZ_H); unsigned char* usnap = carve(SZ_U); unsigned char* xmid = carve((size_t)NTOK * D * 4); unsigned char* hmid = carve(SZ_H);
    nv::WsAlloc al{ws, off, ws_size}; nv::Bufs b; nv::alloc_bufs(al, d, b, 1024, 1280, 1280);
    if (al.off > ws_size) { fprintf(stderr, "kernel_launch(debug): workspace too small (%zu > %zu)\n", al.off, ws_size); return; }
    hipMemsetAsync(ws + WS_CTL, 0, CTL_BYTES, stream); hipMemsetAsync(stat, 0, 4096, stream);
    p.out = fake - OUT_CKV; p.xres = xf;
    dbg::Hook hk; hk.st = stream; hk.d = d; hk.o = o; hk.b = b; hk.p = p; hk.ws = ws; hk.stat = stat; hk.xf = xf; hk.fake = fake; hk.h0s = h0s; hk.usnap = usnap; hk.xmid = xmid; hk.hmid = hmid; hk.TL = FX_TL;
    nv::GpuExec ex{stream, &hk}; nv::forward(ex, d, in, o, b, 4);
    const long ny = (long)16 * 256 * D;
    hipLaunchKernelGGL(dbg::k_sumsq, dim3(1024), dim3(256), 0, stream, (const float*)o.y_prompt, ny, stat + 2 * dbg::NID);
    hipLaunchKernelGGL(dbg::k_final, dim3(1), dim3(64), 0, stream, stat, 0.03f, ny);
    hipLaunchKernelGGL(dbg::k_apply, dim3(1024), dim3(256), 0, stream, o.y_prompt, ny, o.y_sample, (const float*)stat);
#endif
}
```
